# Optimizing an MI355X kernel written in HIP

```python
import math
import jax, jax.numpy as jnp
from jax import lax
import numpy as np

D_MODEL = 1024
BATCH = 8
SEQ = 8192
DEPTH = 4

HEAD_DIM = 64
NSA_HEADS = 12
NSA_KV_HEADS = 4
NSA_GROUP = NSA_HEADS // NSA_KV_HEADS
NSA_WIDTH = NSA_HEADS * HEAD_DIM
NSA_KV_WIDTH = NSA_KV_HEADS * HEAD_DIM
N_BRANCH = 3
CMP_LEN = 32
CMP_STRIDE = 16
CMP_HIDDEN = 4 * HEAD_DIM
SEL_BLOCK = 64
SEL_TOP = 16
WINDOW = 512
Q_BLOCK = 128
GMLP_CHUNK = 128
GMLP_GROUPS = 12
GMLP_WIDTH = 3 * D_MODEL // 4
GMLP_GROUP_DIM = GMLP_WIDTH // GMLP_GROUPS
MEM_LEN = 256
MEM_HEADS = 4
MEM_WIDTH = MEM_HEADS * HEAD_DIM
D_FF = -(-8 * D_MODEL // (3 * 256)) * 256
ROPE_THETA = 10000.0
NORM_EPS = 1e-6
NEG_INF = -1e30
FORCE_BONUS = 1e4
NSA_IN = NSA_WIDTH + 6 * NSA_KV_WIDTH + N_BRANCH * NSA_HEADS + MEM_WIDTH
GMLP_IN = 2 * GMLP_WIDTH + MEM_WIDTH

kernel_name = 'hybrid_gmlp_nsa_interleaved'


def rmsnorm(x, g):
    xf = x.astype(jnp.float32)
    y = xf * lax.rsqrt(jnp.mean(xf * xf, axis=-1, keepdims=True) + NORM_EPS)
    return y.astype(x.dtype) * g


def rope(x):
    s, d = x.shape[1], x.shape[-1]
    half = d // 2
    pos = jnp.arange(s, dtype=jnp.float32)
    inv = ROPE_THETA ** (-jnp.arange(half, dtype=jnp.float32) / half)
    ang = pos[:, None] * inv[None, :]
    cos = jnp.cos(ang)[None, :, None, :]
    sin = jnp.sin(ang)[None, :, None, :]
    xf = x.astype(jnp.float32)
    x1, x2 = xf[..., :half], xf[..., half:]
    return jnp.concatenate([x1 * cos - x2 * sin, x2 * cos + x1 * sin], axis=-1).astype(x.dtype)


def swiglu(h, wg, wu, wd):
    return (jax.nn.silu(h @ wg) * (h @ wu)) @ wd


def mem_cross_attention(q, mem_n, w_kv):
    b, s, _ = q.shape
    m = mem_n.shape[1]
    q = q.reshape(b, s, MEM_HEADS, HEAD_DIM)
    k, v = jnp.split(mem_n @ w_kv, 2, axis=-1)
    k = k.reshape(b, m, MEM_HEADS, HEAD_DIM)
    v = v.reshape(b, m, MEM_HEADS, HEAD_DIM)
    sc = jnp.einsum('bshd,bmhd->bhsm', q, k).astype(jnp.float32) * (HEAD_DIM ** -0.5)
    p = jax.nn.softmax(sc, axis=-1).astype(v.dtype)
    return jnp.einsum('bhsm,bmhd->bshd', p, v).reshape(b, s, MEM_WIDTH)


def gmlp_mixer(h, w_in, v_gain, w_s, b_s):
    b, s, _ = h.shape
    proj = h @ w_in
    z, mem_q = proj[..., :2 * GMLP_WIDTH], proj[..., 2 * GMLP_WIDTH:]
    u, v = jnp.split(jax.nn.gelu(z), 2, axis=-1)
    nc = s // GMLP_CHUNK
    vn = rmsnorm(v, v_gain).reshape(b, nc, GMLP_CHUNK, GMLP_GROUPS, GMLP_GROUP_DIM)
    causal = jnp.tril(jnp.ones((GMLP_CHUNK, GMLP_CHUNK), dtype=bool))
    w = jnp.where(causal[None], w_s, jnp.zeros((), w_s.dtype))
    mixed = jnp.einsum('gts,bcsgd->bctgd', w, vn) + b_s.T[None, None, :, :, None]
    return u * mixed.reshape(b, s, GMLP_WIDTH), mem_q


def compress_blocks(k, pe, w1, w2):
    b, s, g, d = k.shape
    kc = k.reshape(b, s // CMP_STRIDE, CMP_STRIDE, g, d)
    blocks = jnp.concatenate([kc[:, :-1], kc[:, 1:]], axis=2) + pe[None, None, :, None, :]
    flat = blocks.transpose(0, 1, 3, 2, 4).reshape(b, s // CMP_STRIDE - 1, g, CMP_LEN * d)
    return jax.nn.silu(flat @ w1) @ w2


def selection_map(s):
    nc = s // CMP_STRIDE - 1
    nb = s // SEL_BLOCK
    c0 = jnp.arange(nc) * CMP_STRIDE
    b0 = jnp.arange(nb) * SEL_BLOCK
    lo = jnp.maximum(c0[:, None], b0[None, :])
    hi = jnp.minimum(c0[:, None] + CMP_LEN, b0[None, :] + SEL_BLOCK)
    return jnp.clip(hi - lo, 0).astype(jnp.float32) / CMP_LEN


def nsa_single(q, kc, vc, ks, vs, kw, vw, gates, sel_map):
    s = q.shape[0]
    nc = kc.shape[0]
    nb = s // SEL_BLOCK
    n_sel = min(SEL_TOP, nb)
    scale = HEAD_DIM ** -0.5
    qg = q.reshape(s, NSA_KV_HEADS, NSA_GROUP, HEAD_DIM)
    gg = gates.reshape(s, NSA_KV_HEADS, NSA_GROUP, N_BRANCH)
    ks_blk = ks.reshape(nb, SEL_BLOCK, NSA_KV_HEADS, HEAD_DIM).transpose(2, 0, 1, 3)
    vs_blk = vs.reshape(nb, SEL_BLOCK, NSA_KV_HEADS, HEAD_DIM).transpose(2, 0, 1, 3)
    kw_pad = jnp.pad(kw, ((WINDOW, 0), (0, 0), (0, 0)))
    vw_pad = jnp.pad(vw, ((WINDOW, 0), (0, 0), (0, 0)))
    cmp_end = jnp.arange(nc) * CMP_STRIDE + (CMP_LEN - 1)
    blk_ids = jnp.arange(nb)
    in_blk = jnp.arange(SEL_BLOCK)
    win_off = jnp.arange(Q_BLOCK + WINDOW) - WINDOW
    gather = jax.vmap(lambda kb, ib: kb[ib], in_axes=(0, 1), out_axes=1)

    def block(i):
        t0 = i * Q_BLOCK
        tq = t0 + jnp.arange(Q_BLOCK)
        qb = lax.dynamic_slice_in_dim(qg, t0, Q_BLOCK, 0)
        gb = lax.dynamic_slice_in_dim(gg, t0, Q_BLOCK, 0)
        ok_c = cmp_end[None, :] <= tq[:, None]
        sc = jnp.einsum('qgrd,cgd->qgrc', qb, kc).astype(jnp.float32) * scale
        sc = jnp.where(ok_c[:, None, None, :], sc, NEG_INF)
        p_c = jax.nn.softmax(sc, axis=-1) * jnp.any(ok_c, axis=-1).astype(jnp.float32)[:, None, None, None]
        o_c = jnp.einsum('qgrc,cgd->qgrd', p_c.astype(vc.dtype), vc)
        imp = jnp.einsum('qgrc,cn->qgn', p_c, sel_map)
        cur = tq // SEL_BLOCK
        forced = (blk_ids[None, :] == 0) | (blk_ids[None, :] == cur[:, None]) | (blk_ids[None, :] == cur[:, None] - 1)
        imp = imp + jnp.where(forced, FORCE_BONUS, 0.0)[:, None, :]
        imp = jnp.where((blk_ids[None, :] <= cur[:, None])[:, None, :], imp, NEG_INF)
        _, idx = lax.top_k(imp, n_sel)
        k_sel = gather(ks_blk, idx).reshape(Q_BLOCK, NSA_KV_HEADS, n_sel * SEL_BLOCK, HEAD_DIM)
        v_sel = gather(vs_blk, idx).reshape(Q_BLOCK, NSA_KV_HEADS, n_sel * SEL_BLOCK, HEAD_DIM)
        pos_sel = (idx[..., None] * SEL_BLOCK + in_blk).reshape(Q_BLOCK, NSA_KV_HEADS, n_sel * SEL_BLOCK)
        ok_s = pos_sel <= tq[:, None, None]
        ss = jnp.einsum('qgrd,qgmd->qgrm', qb, k_sel).astype(jnp.float32) * scale
        ss = jnp.where(ok_s[:, :, None, :], ss, NEG_INF)
        o_s = jnp.einsum('qgrm,qgmd->qgrd', jax.nn.softmax(ss, axis=-1).astype(v_sel.dtype), v_sel)
        k_win = lax.dynamic_slice_in_dim(kw_pad, t0, Q_BLOCK + WINDOW, 0)
        v_win = lax.dynamic_slice_in_dim(vw_pad, t0, Q_BLOCK + WINDOW, 0)
        pos_w = t0 + win_off
        ok_w = (pos_w[None, :] >= 0) & (pos_w[None, :] <= tq[:, None]) & (pos_w[None, :] > tq[:, None] - WINDOW)
        sw = jnp.einsum('qgrd,kgd->qgrk', qb, k_win).astype(jnp.float32) * scale
        sw = jnp.where(ok_w[:, None, None, :], sw, NEG_INF)
        o_w = jnp.einsum('qgrk,kgd->qgrd', jax.nn.softmax(sw, axis=-1).astype(v_win.dtype), v_win)
        o = gb[..., 0:1] * o_c + gb[..., 1:2] * o_s + gb[..., 2:3] * o_w
        return o.reshape(Q_BLOCK, NSA_WIDTH)

    out = lax.map(block, jnp.arange(s // Q_BLOCK))
    return out.reshape(s, NSA_WIDTH)


def nsa_mixer(h, w_in, pe_k, pe_v, ck_w1, ck_w2, cv_w1, cv_w2):
    b, s, _ = h.shape
    sizes = [NSA_WIDTH] + [NSA_KV_WIDTH] * 6 + [N_BRANCH * NSA_HEADS, MEM_WIDTH]
    offsets = [int(o) for o in np.cumsum(sizes)[:-1]]
    q, k_cmp, v_cmp, k_slc, v_slc, k_win, v_win, g, mem_q = jnp.split(h @ w_in, offsets, axis=-1)
    heads = lambda t, n: t.reshape(b, s, n, HEAD_DIM)
    q = rope(heads(q, NSA_HEADS))
    kc = compress_blocks(rope(heads(k_cmp, NSA_KV_HEADS)), pe_k, ck_w1, ck_w2)
    vc = compress_blocks(heads(v_cmp, NSA_KV_HEADS), pe_v, cv_w1, cv_w2)
    ks = rope(heads(k_slc, NSA_KV_HEADS))
    vs = heads(v_slc, NSA_KV_HEADS)
    kw = rope(heads(k_win, NSA_KV_HEADS))
    vw = heads(v_win, NSA_KV_HEADS)
    gates = jax.nn.sigmoid(g.astype(jnp.float32)).astype(h.dtype).reshape(b, s, NSA_HEADS, N_BRANCH)
    sel_map = selection_map(s)
    out = lax.map(lambda a: nsa_single(a[0], a[1], a[2], a[3], a[4], a[5], a[6], a[7], sel_map),
                  (q, kc, vc, ks, vs, kw, vw, gates))
    return out, mem_q


def setup_inputs(seed: int = 0) -> dict:
    key = jax.random.key(seed)
    k = jax.random.split(key, 23)
    n_a = (DEPTH + 1) // 2
    n_b = DEPTH // 2
    nrm = lambda kk, shape, sc: jax.random.normal(kk, shape, jnp.float32) * sc
    out_sc = (2.0 * DEPTH) ** -0.5
    return {
        'x': nrm(k[0], (BATCH, SEQ, D_MODEL), 1.0),
        'mem': nrm(k[1], (BATCH, MEM_LEN, D_MODEL), 1.0),
        'norm_mix': 1.0 + nrm(k[2], (DEPTH, D_MODEL), 0.02),
        'norm_ffn': 1.0 + nrm(k[3], (DEPTH, D_MODEL), 0.02),
        'norm_mem': 1.0 + nrm(k[4], (DEPTH, D_MODEL), 0.02),
        'norm_final': 1.0 + nrm(k[5], (D_MODEL,), 0.02),
        'w_mem_kv': nrm(k[6], (DEPTH, D_MODEL, 2 * MEM_WIDTH), D_MODEL ** -0.5),
        'ffn_w_gate': nrm(k[7], (DEPTH, D_MODEL, D_FF), D_MODEL ** -0.5),
        'ffn_w_up': nrm(k[8], (DEPTH, D_MODEL, D_FF), D_MODEL ** -0.5),
        'ffn_w_down': nrm(k[9], (DEPTH, D_FF, D_MODEL), D_FF ** -0.5 * out_sc),
        'gmlp_w_in': nrm(k[10], (n_a, D_MODEL, GMLP_IN), D_MODEL ** -0.5),
        'gmlp_v_norm': 1.0 + nrm(k[11], (n_a, GMLP_WIDTH), 0.02),
        'gmlp_w_s': nrm(k[12], (n_a, GMLP_GROUPS, GMLP_CHUNK, GMLP_CHUNK), GMLP_CHUNK ** -0.5),
        'gmlp_b_s': 1.0 + nrm(k[13], (n_a, GMLP_GROUPS, GMLP_CHUNK), 0.02),
        'gmlp_w_out': nrm(k[14], (n_a, GMLP_WIDTH + MEM_WIDTH, D_MODEL), (GMLP_WIDTH + MEM_WIDTH) ** -0.5 * out_sc),
        'nsa_w_in': nrm(k[15], (n_b, D_MODEL, NSA_IN), D_MODEL ** -0.5),
        'nsa_pe_k': nrm(k[16], (n_b, CMP_LEN, HEAD_DIM), 0.1),
        'nsa_pe_v': nrm(k[17], (n_b, CMP_LEN, HEAD_DIM), 0.1),
        'nsa_ck_w1': nrm(k[18], (n_b, CMP_LEN * HEAD_DIM, CMP_HIDDEN), (CMP_LEN * HEAD_DIM) ** -0.5),
        'nsa_ck_w2': nrm(k[19], (n_b, CMP_HIDDEN, HEAD_DIM), CMP_HIDDEN ** -0.5),
        'nsa_cv_w1': nrm(k[20], (n_b, CMP_LEN * HEAD_DIM, CMP_HIDDEN), (CMP_LEN * HEAD_DIM) ** -0.5),
        'nsa_cv_w2': nrm(k[21], (n_b, CMP_HIDDEN, HEAD_DIM), CMP_HIDDEN ** -0.5),
        'nsa_w_out': nrm(k[22], (n_b, NSA_WIDTH + MEM_WIDTH, D_MODEL), (NSA_WIDTH + MEM_WIDTH) ** -0.5 * out_sc),
    }


def reference(x, mem, norm_mix, norm_ffn, norm_mem, norm_final, w_mem_kv, ffn_w_gate, ffn_w_up, ffn_w_down,
              gmlp_w_in, gmlp_v_norm, gmlp_w_s, gmlp_b_s, gmlp_w_out,
              nsa_w_in, nsa_pe_k, nsa_pe_v, nsa_ck_w1, nsa_ck_w2, nsa_cv_w1, nsa_cv_w2, nsa_w_out):
    for i in range(DEPTH):
        j = i // 2
        h = rmsnorm(x, norm_mix[i])
        mem_n = rmsnorm(mem, norm_mem[i])
        if i % 2 == 0:
            mix, mem_q = gmlp_mixer(h, gmlp_w_in[j], gmlp_v_norm[j], gmlp_w_s[j], gmlp_b_s[j])
            w_out = gmlp_w_out[j]
        else:
            mix, mem_q = nsa_mixer(h, nsa_w_in[j], nsa_pe_k[j], nsa_pe_v[j], nsa_ck_w1[j], nsa_ck_w2[j],
                                   nsa_cv_w1[j], nsa_cv_w2[j])
            w_out = nsa_w_out[j]
        mem_o = mem_cross_attention(mem_q, mem_n, w_mem_kv[i])
        x = x + jnp.concatenate([mix, mem_o], axis=-1) @ w_out
        h = rmsnorm(x, norm_ffn[i])
        x = x + swiglu(h, ffn_w_gate[i], ffn_w_up[i], ffn_w_down[i])
    return rmsnorm(x, norm_final)
```

```cpp
#include <hip/hip_runtime.h>
#include <hip/hip_cooperative_groups.h>
#include <cstdio>
#include <cstdint>
namespace cg = cooperative_groups;
#define GAS __attribute__((address_space(1)))

#ifndef MK_MULTI
#define MK_MULTI 0
#endif

namespace pg8 {
#define PG8_LAS __attribute__((address_space(3)))
typedef unsigned short bf16_t;
typedef short bf16x8 __attribute__((ext_vector_type(8)));
typedef float f32x4 __attribute__((ext_vector_type(4)));
typedef unsigned u32x4 __attribute__((ext_vector_type(4)));
constexpr int BM = 256, BK = 64, HALF = 128, HTB = HALF * BK * 2  , STAGE_BYTES = 8 * HTB, NXCD = 8, WGM = 8;

__host__ __device__ __forceinline__ int lds_byte(int r, int c) { const int st = (r >> 4) * 2 + (c >> 5), rr = r & 15, cc = c & 31, ob = rr * 64 + cc * 2; return st * 1024 + (ob ^ (((ob >> 9) & 1) << 5)); }
__host__ __device__ __forceinline__ void stage_rc(int b, int& R, int& C) { const int st = b / 1024, sb = b % 1024, swz = sb ^ (((sb >> 9) & 1) << 5); R = (st >> 1) * 16 + swz / 64; C = (st & 1) * 32 + (swz % 64) / 2; }
__host__ __device__ __forceinline__ int perm32(int rho) { const int n = rho >> 4, i = rho & 15; return 8 * (i >> 2) + 4 * n + (i & 3); }

struct Unit { int pm, pn; };
struct Gemm { const bf16_t* A; const bf16_t* Bt; int M, N, K, lda; };

struct StaticOrder {
    int nM, nN, nwg, G, c, rev;
    __host__ __device__ void init(int M, int N, int G_, int c_, int rev_ = 0) { nM = M / BM; nN = N / BM; nwg = nM * nN; G = G_; c = c_; rev = rev_; }
    __host__ __device__ bool next(int i, Unit& u) const {
        const long L = (long)i * G + c; if (L >= nwg) return false;
        int wgid = (int)L; { const int q = nwg / NXCD, r = nwg % NXCD, xcd = wgid % NXCD, off = wgid / NXCD; wgid = (xcd < r ? xcd * (q + 1) : r * (q + 1) + (xcd - r) * q) + off; }
        const int nig = WGM * nN, gid = wgid / nig, fm = gid * WGM, gsz = (nM - fm) < WGM ? (nM - fm) : WGM;
        u.pm = fm + ((wgid % nig) % gsz); u.pn = (wgid % nig) / gsz; if (rev) u.pm = nM - 1 - u.pm; return true;
    }
    __device__ __forceinline__ void a_ready(const Unit&) const {}
    __device__ __forceinline__ void done(const Unit&) const {}
};


__device__ __forceinline__ unsigned cvt_pk_bf16(float lo, float hi) { unsigned r; asm volatile("v_cvt_pk_bf16_f32 %0, %1, %2" : "=v"(r) : "v"(lo), "v"(hi)); return r; }

typedef unsigned u32x2 __attribute__((ext_vector_type(2)));
__device__ __forceinline__ float xsum16(float v) { const auto r = __builtin_amdgcn_permlane16_swap(__float_as_uint(v), __float_as_uint(v), false, false); return __uint_as_float(r[0]) + __uint_as_float(r[1]); }
__device__ __forceinline__ float xsum32(float v) { const auto r = __builtin_amdgcn_permlane32_swap(__float_as_uint(v), __float_as_uint(v), false, false); return __uint_as_float(r[0]) + __uint_as_float(r[1]); }
__device__ __forceinline__ float xmax16(float v) { const auto r = __builtin_amdgcn_permlane16_swap(__float_as_uint(v), __float_as_uint(v), false, false); return fmaxf(__uint_as_float(r[0]), __uint_as_float(r[1])); }
__device__ __forceinline__ float xmax32(float v) { const auto r = __builtin_amdgcn_permlane32_swap(__float_as_uint(v), __float_as_uint(v), false, false); return fmaxf(__uint_as_float(r[0]), __uint_as_float(r[1])); }

__device__ __forceinline__ float bf2f(unsigned short h) { return __uint_as_float((unsigned)h << 16); }
__device__ __forceinline__ float fast_sigmoid(float x) { return __builtin_amdgcn_rcpf(1.f + __builtin_amdgcn_exp2f(-1.4426950408889634f * x)); }
__device__ __forceinline__ float gelu_tanh(float x) { const float u = 0.7978845608028654f * (x + 0.044715f * x * x * x); return x * fast_sigmoid(2.f * u); }
__device__ __forceinline__ float silu_f(float x) { return x * fast_sigmoid(x); }
__device__ __forceinline__ u32x4 pack8(const f32x4 a, const f32x4 b) { u32x4 w; w.x = cvt_pk_bf16(a[0], a[1]); w.y = cvt_pk_bf16(a[2], a[3]); w.z = cvt_pk_bf16(b[0], b[1]); w.w = cvt_pk_bf16(b[2], b[3]); return w; }
__device__ __forceinline__ float sumsq4(const f32x4 a) { return (a[0] * a[0] + a[1] * a[1]) + (a[2] * a[2] + a[3] * a[3]); }
constexpr float NORM_EPS = 1e-6f;
__device__ __forceinline__ float row_rinv16(const float* ssq, int row) {
    const GAS f32x4* p = (const GAS f32x4*)(ssq + (size_t)row * 16); const f32x4 a = p[0], b = p[1], c = p[2], d = p[3];
    const float s = (((a[0] + a[1]) + (a[2] + a[3])) + ((b[0] + b[1]) + (b[2] + b[3]))) + (((c[0] + c[1]) + (c[2] + c[3])) + ((d[0] + d[1]) + (d[2] + d[3])));
    return __builtin_amdgcn_rsqf(s * (1.0f / 1024.0f) + NORM_EPS);
}
constexpr float QSCALE = 0.125f * 1.4426950408889634f;


struct EpiGmlpIn { static constexpr bool PERM = true, AFTER_DRAIN = false;
    const float* ssq; bf16_t* U; bf16_t* V; bf16_t* MQ; float* vssq;
    __device__ __forceinline__ void operator()(const f32x4 (&acc)[2][2][4][2], const Unit& u, int wr, int wc, int fr, int fq) const {
        const int pn = u.pn;
#pragma unroll
        for (int ai = 0; ai < 2; ++ai)
#pragma unroll
            for (int m = 0; m < 4; ++m) {
                const int row = u.pm * BM + ai * HALF + wr * 64 + m * 16 + fr;
                const float rinv = row_rinv16(ssq, row);
#pragma unroll
                for (int bj = 0; bj < 2; ++bj) {
                    const int col = pn * BM + bj * HALF + wc * 32 + 8 * fq;
                    f32x4 v0 = acc[ai][bj][m][0] * rinv, v1 = acc[ai][bj][m][1] * rinv;
                    if (pn < 6) {
#pragma unroll
                        for (int i = 0; i < 4; ++i) { v0[i] = gelu_tanh(v0[i]); v1[i] = gelu_tanh(v1[i]); }
                        if (pn < 3) { *(GAS u32x4*)(U + (size_t)row * 768 + col) = pack8(v0, v1); }
                        else {
                            *(GAS u32x4*)(V + (size_t)row * 768 + (col - 768)) = pack8(v0, v1);
                            float s = sumsq4(v0) + sumsq4(v1); s = pg8::xsum16(s); s = pg8::xsum32(s);
                            if (fq == 0) ((GAS float*)vssq)[(size_t)row * 24 + (pn - 3) * 8 + bj * 4 + wc] = s;
                        }
                    } else { v0 = v0 * QSCALE; v1 = v1 * QSCALE; *(GAS u32x4*)(MQ + (size_t)row * 256 + (col - 1536)) = pack8(v0, v1); }
                }
            }
    }
};

struct EpiNsaIn { static constexpr bool PERM = true, AFTER_DRAIN = false;
    const float* ssq; const float* rope; bf16_t* Q; bf16_t* KVG; bf16_t* MQ; float* G;
    size_t kvg_stride;
    __device__ __forceinline__ void operator()(const f32x4 (&acc)[2][2][4][2], const Unit& u, int wr, int wc, int fr, int fq) const {
        const int pn = u.pn;
        const bool rope_t = (pn <= 3) || pn == 5 || pn == 7;
        const float sc = (pn < 3 || pn == 9) ? QSCALE : 1.0f;
#pragma unroll
        for (int ai = 0; ai < 2; ++ai)
#pragma unroll
            for (int m = 0; m < 4; ++m) {
                const int row = u.pm * BM + ai * HALF + wr * 64 + m * 16 + fr;
                const float rinv = row_rinv16(ssq, row);
                f32x4 lo0 = acc[ai][0][m][0] * rinv, lo1 = acc[ai][0][m][1] * rinv, hi0 = acc[ai][1][m][0] * rinv, hi1 = acc[ai][1][m][1] * rinv;
                if (pn == 10) {
#pragma unroll
                    for (int i = 0; i < 4; ++i) {
                        int col = wc * 32 + 8 * fq + i;
                        if (col < 36) ((GAS float*)G)[(size_t)row * 36 + col] = fast_sigmoid(lo0[i]);
                        col += 4;
                        if (col < 36) ((GAS float*)G)[(size_t)row * 36 + col] = fast_sigmoid(lo1[i]);
                    }
                    continue;
                }
                const int pos = row & 8191;
                if (rope_t) {
                    const GAS f32x4* cs = (const GAS f32x4*)(rope + ((size_t)pos * 32 + 8 * fq) * 2);
                    const f32x4 c01 = cs[0], c23 = cs[1], c45 = cs[2], c67 = cs[3];
#define ROT(a, b, c, s) do { const float na_ = (a) * (c) - (b) * (s), nb_ = (b) * (c) + (a) * (s); (a) = na_; (b) = nb_; } while (0)
                    ROT(lo0[0], hi0[0], c01[0], c01[1]); ROT(lo0[1], hi0[1], c01[2], c01[3]); ROT(lo0[2], hi0[2], c23[0], c23[1]); ROT(lo0[3], hi0[3], c23[2], c23[3]);
                    ROT(lo1[0], hi1[0], c45[0], c45[1]); ROT(lo1[1], hi1[1], c45[2], c45[3]); ROT(lo1[2], hi1[2], c67[0], c67[1]); ROT(lo1[3], hi1[3], c67[2], c67[3]);
#undef ROT
                }
                lo0 = lo0 * sc; lo1 = lo1 * sc; hi0 = hi0 * sc; hi1 = hi1 * sc;
                bf16_t* p;
                if (pn < 3) p = Q + (size_t)row * 768 + (pn * 4 + wc) * 64 + 8 * fq;
                else if (pn == 9) p = MQ + (size_t)row * 256 + wc * 64 + 8 * fq;
                else p = KVG + (size_t)(pn - 3) * kvg_stride + ((size_t)((row >> 13) * 4 + wc) * 8192 + pos) * 64 + 8 * fq;
                *(u32x4*)p = pack8(lo0, lo1); *(GAS u32x4*)(p + 32) = pack8(hi0, hi1);
            }
    }
};

struct EpiResid { static constexpr bool PERM = true, AFTER_DRAIN = false;
    const float* xsrc; float* xdst; bf16_t* xb; float* ssq;
    __device__ __forceinline__ void operator()(const f32x4 (&acc)[2][2][4][2], const Unit& u, int wr, int wc, int fr, int fq) const {
#pragma unroll
        for (int ai = 0; ai < 2; ++ai) {
            f32x4 xv[4][2][2];
#pragma unroll
            for (int m = 0; m < 4; ++m)
#pragma unroll
                for (int bj = 0; bj < 2; ++bj) {
                    const size_t off = (size_t)(u.pm * BM + ai * HALF + wr * 64 + m * 16 + fr) * 1024 + u.pn * BM + bj * HALF + wc * 32 + 8 * fq;
                    xv[m][bj][0] = __builtin_nontemporal_load((const GAS f32x4*)(xsrc + off)); xv[m][bj][1] = __builtin_nontemporal_load((const GAS f32x4*)(xsrc + off + 4));
                }
            asm volatile("" ::: "memory");
#pragma unroll
            for (int m = 0; m < 4; ++m) {
                const int row = u.pm * BM + ai * HALF + wr * 64 + m * 16 + fr; float s = 0.f;
#pragma unroll
                for (int bj = 0; bj < 2; ++bj) {
                    const size_t off = (size_t)row * 1024 + u.pn * BM + bj * HALF + wc * 32 + 8 * fq;
                    const f32x4 x0 = xv[m][bj][0] + acc[ai][bj][m][0], x1 = xv[m][bj][1] + acc[ai][bj][m][1];
                    __builtin_nontemporal_store(x0, (GAS f32x4*)(xdst + off)); __builtin_nontemporal_store(x1, (GAS f32x4*)(xdst + off + 4)); *(GAS u32x4*)(xb + off) = pack8(x0, x1);
                    s += sumsq4(x0) + sumsq4(x1);
                }
                s = pg8::xsum16(s); s = pg8::xsum32(s);
                if (fq == 0) ((GAS float*)ssq)[(size_t)row * 16 + u.pn * 4 + wc] = s;
            }
            asm volatile("" ::: "memory");
        }
    }
};

typedef float f32x2e __attribute__((ext_vector_type(2)));
struct EpiGateUp { static constexpr bool PERM = true, AFTER_DRAIN = false;
    const float* ssq; bf16_t* hid;
    static __device__ __forceinline__ unsigned swiglu2(float g0, float g1, float u0, float u1, float a, float r2) {
        const f32x2e g = (f32x2e){g0, g1}, u = (f32x2e){u0, u1};
        const f32x2e t = g * a;
        f32x2e e; e.x = __builtin_amdgcn_exp2f(t.x); e.y = __builtin_amdgcn_exp2f(t.y);
        const f32x2e d = e + 1.0f;
        f32x2e r; r.x = __builtin_amdgcn_rcpf(d.x); r.y = __builtin_amdgcn_rcpf(d.y);
        const f32x2e h = (g * u) * (r * r2);
        return cvt_pk_bf16(h.x, h.y);
    }
    __device__ __forceinline__ void operator()(const f32x4 (&acc)[2][2][4][2], const Unit& u, int wr, int wc, int fr, int fq) const {
#pragma unroll
        for (int ai = 0; ai < 2; ++ai)
#pragma unroll
            for (int m = 0; m < 4; ++m) {
                const int row = u.pm * BM + ai * HALF + wr * 64 + m * 16 + fr;
                const float rinv = row_rinv16(ssq, row);
                const float a = rinv * -1.4426950408889634f, r2 = rinv * rinv;
                u32x4 w;
                w.x = swiglu2(acc[ai][0][m][0][0], acc[ai][0][m][0][1], acc[ai][1][m][0][0], acc[ai][1][m][0][1], a, r2);
                w.y = swiglu2(acc[ai][0][m][0][2], acc[ai][0][m][0][3], acc[ai][1][m][0][2], acc[ai][1][m][0][3], a, r2);
                w.z = swiglu2(acc[ai][0][m][1][0], acc[ai][0][m][1][1], acc[ai][1][m][1][0], acc[ai][1][m][1][1], a, r2);
                w.w = swiglu2(acc[ai][0][m][1][2], acc[ai][0][m][1][3], acc[ai][1][m][1][2], acc[ai][1][m][1][3], a, r2);
                *(GAS u32x4*)(hid + (size_t)row * 2816 + u.pn * 128 + wc * 32 + 8 * fq) = w;
            }
    }
};

struct EpiMemKV { static constexpr bool PERM = true, AFTER_DRAIN = false;
    const float* rinv; bf16_t* O;
    __device__ __forceinline__ void operator()(const f32x4 (&acc)[2][2][4][2], const Unit& u, int wr, int wc, int fr, int fq) const {
#pragma unroll
        for (int ai = 0; ai < 2; ++ai)
#pragma unroll
            for (int m = 0; m < 4; ++m) {
                const int row = u.pm * BM + ai * HALF + wr * 64 + m * 16 + fr; const float r = ((const GAS float*)rinv)[row];
#pragma unroll
                for (int bj = 0; bj < 2; ++bj)
                    *(GAS u32x4*)(O + (size_t)row * 2048 + u.pn * BM + bj * HALF + wc * 32 + 8 * fq) = pack8(acc[ai][bj][m][0] * r, acc[ai][bj][m][1] * r);
            }
    }
};

struct EpiCmp1 { static constexpr bool PERM = true, AFTER_DRAIN = false;
    const float* bias; bf16_t* H;
    __device__ __forceinline__ void operator()(const f32x4 (&acc)[2][2][4][2], const Unit& u, int wr, int wc, int fr, int fq) const {
#pragma unroll
        for (int bj = 0; bj < 2; ++bj) {
            const int col = bj * HALF + wc * 32 + 8 * fq;
            const f32x4 b0 = *(const GAS f32x4*)(bias + col), b1 = *(const GAS f32x4*)(bias + col + 4);
#pragma unroll
            for (int ai = 0; ai < 2; ++ai)
#pragma unroll
                for (int m = 0; m < 4; ++m) {
                    const int row = u.pm * BM + ai * HALF + wr * 64 + m * 16 + fr;
                    f32x4 v0 = acc[ai][bj][m][0] + b0, v1 = acc[ai][bj][m][1] + b1;
#pragma unroll
                    for (int i = 0; i < 4; ++i) { v0[i] = silu_f(v0[i]); v1[i] = silu_f(v1[i]); }
                    *(GAS u32x4*)(H + (size_t)row * 256 + col) = pack8(v0, v1);
                }
        }
    }
};

template <class Epi, class Sched, bool ALIGN_EPI = false, bool SP2 = false>
__device__ __forceinline__ void gemm_phase(PG8_LAS unsigned char* lds, const Gemm g, const Sched& S, const Epi& E, int tid_in) {
    int tid0_ = tid_in; asm volatile("" : "+v"(tid0_));
    const int tid = tid0_, wid = __builtin_amdgcn_readfirstlane(tid >> 6), lane = tid & 63, wr = wid >> 2, wc = wid & 3, fr = lane & 15, fq = lane >> 4;
    const int K = g.K, nt = K / BK;
    unsigned voffA[2], voffB[2];
#pragma unroll
    for (int i = 0; i < 2; ++i) { int R, C; stage_rc(tid * 16 + i * 8192, R, C); const int Rb = Epi::PERM ? ((R & ~31) + perm32(R & 31)) : R;
        voffA[i] = (unsigned)(R * g.lda + C) * 2u; voffB[i] = (unsigned)(Rb * K + C) * 2u; }
    const size_t kstep = (size_t)(BK * 2);
    const size_t hstep = (size_t)HALF * K * 2;
    const size_t tstep = 2 * hstep;
    const size_t hstepA = (size_t)HALF * g.lda * 2, tstepA = 2 * hstepA;
    const unsigned ldsw = (unsigned)wid * 1024u;
    const int aoff = lds_byte(wr * 64 + fr, fq * 8), boff = lds_byte(wc * 32 + fr, fq * 8);
#define PG8_SA(b, h) (((b) * 2 + (h)) * HTB)
#define PG8_SB(b, h) ((4 + (b) * 2 + (h)) * HTB)
#define PG8_STAGE(bufoff, gbase, voff) do { _Pragma("unroll") for (int _i = 0; _i < 2; ++_i) \
        __builtin_amdgcn_global_load_lds((const unsigned*)((const char*)(gbase) + (voff)[_i]), (PG8_LAS unsigned*)(lds + (bufoff) + ldsw + _i * 8192), 16, 0, 0); } while (0)
#define PG8_LDA(dst, b, h) do { _Pragma("unroll") for (int m = 0; m < 4; ++m) _Pragma("unroll") for (int k = 0; k < 2; ++k) dst[m][k] = *(const PG8_LAS bf16x8*)(lds + PG8_SA(b, h) + aoff + m * 2048 + k * 1024); } while (0)
#define PG8_LDB(dst, b, h) do { _Pragma("unroll") for (int n = 0; n < 2; ++n) _Pragma("unroll") for (int k = 0; k < 2; ++k) dst[n][k] = *(const PG8_LAS bf16x8*)(lds + PG8_SB(b, h) + boff + n * 2048 + k * 1024); } while (0)
#define PG8_MMA(ai, bj, At, Bt) do { __builtin_amdgcn_s_setprio(1); _Pragma("unroll") for (int m = 0; m < 4; ++m) _Pragma("unroll") for (int n = 0; n < 2; ++n) _Pragma("unroll") for (int k = 0; k < 2; ++k) \
        acc[ai][bj][m][n] = __builtin_amdgcn_mfma_f32_16x16x32_bf16(Bt[n][k], At[m][k], acc[ai][bj][m][n], 0, 0, 0); __builtin_amdgcn_s_setprio(0); } while (0)
#define PG8_WAIT_V(n) asm volatile("s_waitcnt vmcnt(" #n ")" ::: "memory")
#define PG8_WAIT_L(n) asm volatile("s_waitcnt lgkmcnt(" #n ")" ::: "memory")
#define PG8_BAR __builtin_amdgcn_s_barrier()
#define PG8_SCHED __builtin_amdgcn_sched_barrier(0)
    Unit cur, nxt; int ui = 0;
    if (!S.next(0, cur)) return;
    f32x4 acc[2][2][4][2];
    float zf_ = 0.f; asm volatile("" : "+v"(zf_));
#pragma unroll
    for (int a = 0; a < 2; ++a)
#pragma unroll
        for (int b = 0; b < 2; ++b)
#pragma unroll
            for (int m = 0; m < 4; ++m)
#pragma unroll
                for (int n = 0; n < 2; ++n) acc[a][b][m][n] = (f32x4){zf_, zf_, zf_, zf_};
    bf16x8 At[4][2], B0[2][2], B1[2][2];
    const char* cA = (const char*)g.A + (size_t)cur.pm * tstepA; const char* cB = (const char*)g.Bt + (size_t)cur.pn * tstep;
    S.a_ready(cur);
    if constexpr (SP2) {
        PG8_STAGE(PG8_SB(0, 0), cB, voffB); PG8_STAGE(PG8_SB(0, 1), cB + hstep, voffB); PG8_STAGE(PG8_SA(0, 0), cA, voffA); PG8_STAGE(PG8_SA(0, 1), cA + hstepA, voffA);
        if (wr == 1) PG8_BAR;
        PG8_WAIT_V(2); PG8_BAR;
        PG8_STAGE(PG8_SB(1, 0), cB + kstep, voffB); PG8_STAGE(PG8_SA(1, 0), cA + kstep, voffA); PG8_STAGE(PG8_SB(1, 1), cB + hstep + kstep, voffB);
        PG8_WAIT_V(6); PG8_BAR;
    } else {
        PG8_STAGE(PG8_SB(0, 0), cB, voffB); PG8_STAGE(PG8_SA(0, 0), cA, voffA); PG8_STAGE(PG8_SB(0, 1), cB + hstep, voffB); PG8_STAGE(PG8_SA(0, 1), cA + hstepA, voffA);
        if (wr == 1) PG8_BAR;
        PG8_WAIT_V(4); PG8_BAR;
        PG8_STAGE(PG8_SB(1, 0), cB + kstep, voffB); PG8_STAGE(PG8_SA(1, 0), cA + kstep, voffA); PG8_STAGE(PG8_SB(1, 1), cB + hstep + kstep, voffB);
        PG8_WAIT_V(6); PG8_BAR;
    }
    for (;;) {
        const bool has_next = S.next(ui + 1, nxt);
        const char* nA = has_next ? (const char*)g.A + (size_t)nxt.pm * tstepA : cA; const char* nB = has_next ? (const char*)g.Bt + (size_t)nxt.pn * tstep : cB;
        for (int t = 0; t < nt; t += 2) {
            const bool last = (t == nt - 2);
            const char* a1 = cA + (size_t)(t + 1) * kstep;
            const char* a2 = last ? nA : cA + (size_t)(t + 2) * kstep; const char* b2 = last ? nB : cB + (size_t)(t + 2) * kstep;
            const char* a3 = a2 + kstep; const char* b3 = b2 + kstep;
            if (last && has_next) S.a_ready(nxt);
            if constexpr (SP2) {
            PG8_LDB(B0, 0, 0); PG8_LDB(B1, 0, 1); PG8_SCHED; PG8_LDA(At, 0, 0); PG8_STAGE(PG8_SA(1, 1), a1 + hstepA, voffA);
            PG8_WAIT_V(8); PG8_WAIT_L(0); PG8_BAR; PG8_MMA(0, 0, At, B0); PG8_MMA(0, 1, At, B1); PG8_BAR; PG8_SCHED;
            PG8_LDA(At, 0, 1); PG8_STAGE(PG8_SB(0, 0), b2, voffB); PG8_STAGE(PG8_SB(0, 1), b2 + hstep, voffB); PG8_STAGE(PG8_SA(0, 0), a2, voffA);
            PG8_WAIT_V(8); PG8_WAIT_L(0); PG8_BAR; PG8_MMA(1, 0, At, B0); PG8_MMA(1, 1, At, B1); PG8_BAR; PG8_SCHED;
            PG8_LDB(B0, 1, 0); PG8_LDB(B1, 1, 1); PG8_SCHED; PG8_LDA(At, 1, 0); PG8_STAGE(PG8_SA(0, 1), a2 + hstepA, voffA);
            PG8_WAIT_V(8); PG8_WAIT_L(0); PG8_BAR; PG8_MMA(0, 0, At, B0); PG8_MMA(0, 1, At, B1); PG8_BAR; PG8_SCHED;
            PG8_LDA(At, 1, 1); PG8_STAGE(PG8_SB(1, 0), b3, voffB); PG8_STAGE(PG8_SB(1, 1), b3 + hstep, voffB); PG8_STAGE(PG8_SA(1, 0), a3, voffA);
            PG8_WAIT_V(8); PG8_WAIT_L(0); PG8_BAR; PG8_MMA(1, 0, At, B0); PG8_MMA(1, 1, At, B1); PG8_BAR; PG8_SCHED;
            } else {
            PG8_LDB(B0, 0, 0); PG8_SCHED; PG8_LDA(At, 0, 0); PG8_STAGE(PG8_SA(1, 1), a1 + hstepA, voffA);
            PG8_WAIT_L(8); PG8_BAR; PG8_WAIT_L(0); PG8_MMA(0, 0, At, B0); PG8_BAR; PG8_SCHED;
            PG8_LDB(B1, 0, 1); PG8_STAGE(PG8_SB(0, 0), b2, voffB);
            PG8_BAR; PG8_WAIT_L(0); PG8_MMA(0, 1, At, B1); PG8_BAR;
            PG8_LDA(At, 0, 1); PG8_STAGE(PG8_SA(0, 0), a2, voffA);
            PG8_BAR; PG8_WAIT_L(0); PG8_MMA(1, 0, At, B0); PG8_BAR; PG8_SCHED;
            PG8_STAGE(PG8_SB(0, 1), b2 + hstep, voffB);
            PG8_WAIT_V(6); PG8_BAR; PG8_MMA(1, 1, At, B1); PG8_BAR;
            PG8_LDB(B0, 1, 0); PG8_SCHED; PG8_LDA(At, 1, 0); PG8_STAGE(PG8_SA(0, 1), a2 + hstepA, voffA);
            PG8_WAIT_L(8); PG8_BAR; PG8_WAIT_L(0); PG8_MMA(0, 0, At, B0); PG8_BAR; PG8_SCHED;
            PG8_LDB(B1, 1, 1); PG8_STAGE(PG8_SB(1, 0), b3, voffB);
            PG8_BAR; PG8_WAIT_L(0); PG8_MMA(0, 1, At, B1); PG8_BAR;
            PG8_LDA(At, 1, 1); PG8_STAGE(PG8_SA(1, 0), a3, voffA);
            PG8_BAR; PG8_WAIT_L(0); PG8_MMA(1, 0, At, B0); PG8_BAR; PG8_SCHED;
            PG8_STAGE(PG8_SB(1, 1), b3 + hstep, voffB);
            PG8_WAIT_V(6); PG8_BAR; PG8_MMA(1, 1, At, B1); PG8_BAR;
            }
        }
        if constexpr (ALIGN_EPI) { if (wr == 0) PG8_BAR; }
        if constexpr (!Epi::AFTER_DRAIN) { E(acc, cur, wr, wc, fr, fq); S.done(cur); }
        if (!has_next) break;
        zf_ = 0.f; asm volatile("" : "+v"(zf_));
#pragma unroll
        for (int a = 0; a < 2; ++a)
#pragma unroll
            for (int b = 0; b < 2; ++b)
#pragma unroll
                for (int m = 0; m < 4; ++m)
#pragma unroll
                    for (int n = 0; n < 2; ++n) acc[a][b][m][n] = (f32x4){zf_, zf_, zf_, zf_};
        cur = nxt; cA = nA; cB = nB; ++ui;
        if constexpr (ALIGN_EPI) { if (wr == 1) PG8_BAR; }
    }
    PG8_WAIT_V(0);
    if constexpr (!ALIGN_EPI) { if (wr == 0) PG8_BAR; }
    PG8_BAR;
    if constexpr (Epi::AFTER_DRAIN) { E.fused(acc, cur, wr, wc, fr, fq, lds, wid, lane); S.done(cur); }
#undef PG8_SA
#undef PG8_SB
#undef PG8_STAGE
#undef PG8_LDA
#undef PG8_LDB
#undef PG8_MMA
#undef PG8_WAIT_V
#undef PG8_WAIT_L
#undef PG8_BAR
#undef PG8_SCHED
}

}

using pg8::bf16_t; using pg8::bf16x8; using pg8::f32x4; using pg8::u32x4; using pg8::u32x2; using pg8::bf2f; using pg8::cvt_pk_bf16;
#define LAS __attribute__((address_space(3)))
typedef short s16x4 __attribute__((ext_vector_type(4)));
constexpr int NWAVES = 8, NTHREADS = 512;
constexpr int DM = 1024, NB = 8, SEQ = 8192, MTOK = NB * SEQ, DFF = 2816, MEMLEN = 256;
constexpr size_t MiB = 1u << 20;
constexpr size_t WS_CTL_BAR = 0;
constexpr size_t WS_MISC = 1 * MiB;
constexpr size_t OFF_MEMRINV = 0, OFF_BIAS1P = 16384, OFF_BIAS1 = 16384 + 65536;
constexpr size_t WS_ROPE = 2 * MiB;
constexpr size_t WS_WMKV = 4 * MiB;
constexpr size_t WS_W = 8 * MiB, W_STRIDE = 27 * MiB;
constexpr size_t OFF_GU = 0, OFF_D = 11534336, OFF_IN = OFF_D + 5767168, OFF_OUT = OFF_IN + 5767168, OFF_CK1 = OFF_OUT + 2097152, OFF_CV1 = OFF_CK1 + 1048576,
                 OFF_CK2 = OFF_CV1 + 1048576, OFF_CV2 = OFF_CK2 + 32768, OFF_WSB = OFF_CV2 + 32768;
static_assert(OFF_WSB + 393216 <= W_STRIDE, "weights per layer");
constexpr size_t WS_MEMB = 116 * MiB;
constexpr size_t WS_MEMKV = 120 * MiB;
constexpr size_t WS_XB = 128 * MiB;
constexpr size_t WS_CAT = 256 * MiB;
constexpr size_t WS_SSQ = 384 * MiB;
constexpr size_t WS_VSSQ = 388 * MiB;
constexpr size_t WS_G = 394 * MiB;
constexpr size_t WS_KCC = 404 * MiB, WS_VCC = 406 * MiB;
constexpr size_t WS_HC = 408 * MiB;
constexpr size_t WS_MQ = 424 * MiB;
constexpr size_t WS_PROJ = 456 * MiB;
constexpr size_t KVG_STRIDE_B = 34 * MiB;
constexpr size_t WS_END = WS_PROJ + 352 * MiB;
static_assert(96 * MiB + 6 * KVG_STRIDE_B <= 352 * MiB, "proj region");

__device__ __forceinline__ bf16x8 mk8(s16x4 a, s16x4 b) { return __builtin_shufflevector(a, b, 0, 1, 2, 3, 4, 5, 6, 7); }
#define MFMA16(a, b, c) __builtin_amdgcn_mfma_f32_16x16x32_bf16((a), (b), (c), 0, 0, 0)
__device__ __forceinline__ float wave_sum(float v) {
    v += __uint_as_float((unsigned)__builtin_amdgcn_ds_swizzle((int)__float_as_uint(v), 0x041f));
    v += __uint_as_float((unsigned)__builtin_amdgcn_ds_swizzle((int)__float_as_uint(v), 0x081f));
    v += __uint_as_float((unsigned)__builtin_amdgcn_ds_swizzle((int)__float_as_uint(v), 0x101f));
    v += __uint_as_float((unsigned)__builtin_amdgcn_ds_swizzle((int)__float_as_uint(v), 0x201f));
    v = pg8::xsum16(v); v = pg8::xsum32(v);
    return v;
}
__device__ __forceinline__ unsigned short f2bf(float f) { return (unsigned short)(cvt_pk_bf16(f, 0.f) & 0xffffu); }

struct Args { const float* in[23]; float* out; unsigned char* ws; int ph_lo, ph_hi; };

__device__ __forceinline__ void cvt_item(const float* src, int ld, int col0, int nvalid, const float* gain, bf16_t* dst, int K, int drow0, int k0, LAS float* scr, int lane) {
    const int n = lane & 31, ncl = (n < nvalid) ? n : 0, kh = lane >> 5;
    float vals[32];
#pragma unroll
    for (int i = 0; i < 32; ++i) vals[i] = ((const GAS float*)src)[(size_t)(k0 + 2 * i + kh) * ld + col0 + ncl];
    if (gain) {
#pragma unroll
        for (int i = 0; i < 32; ++i) vals[i] *= ((const GAS float*)gain)[k0 + 2 * i + kh];
    }
#pragma unroll
    for (int i = 0; i < 32; ++i) scr[(2 * i + kh) * 33 + n] = (n < nvalid) ? vals[i] : 0.f;
    asm volatile("s_waitcnt lgkmcnt(0)" ::: "memory");
    const int c = lane & 7;
#pragma unroll
    for (int j = 0; j < 4; ++j) {
        const int nn = (lane >> 3) + 8 * j; const LAS float* s = scr + (8 * c) * 33 + nn;
        u32x4 o; o.x = cvt_pk_bf16(s[0 * 33], s[1 * 33]); o.y = cvt_pk_bf16(s[2 * 33], s[3 * 33]); o.z = cvt_pk_bf16(s[4 * 33], s[5 * 33]); o.w = cvt_pk_bf16(s[6 * 33], s[7 * 33]);
        *(GAS u32x4*)(dst + (size_t)(drow0 + nn) * K + k0 + 8 * c) = o;
    }
    asm volatile("s_waitcnt lgkmcnt(0)" ::: "memory");
}

struct Job { const float* src; const float* srcB; const float* gain; bf16_t* dst; int K, Nd, ld, kind; };
__device__ __forceinline__ Job job_get(const Args& a, int jidx) {
    Job J; const int i = jidx / 9, t = jidx % 9, j = i >> 1; const bool odd = (i & 1) != 0;
    unsigned char* wb = a.ws + WS_W + (size_t)i * W_STRIDE;
    J.srcB = nullptr; J.gain = nullptr; J.kind = 0; J.K = 1024; J.Nd = 0; J.ld = 0; J.src = nullptr; J.dst = nullptr;
    if (t == 0) { J.src = a.in[7] + (size_t)i * 1024 * 2816; J.srcB = a.in[8] + (size_t)i * 1024 * 2816; J.gain = a.in[3] + i * 1024; J.dst = (bf16_t*)(wb + OFF_GU); J.Nd = 5632; J.ld = 2816; J.kind = 1; }
    else if (t == 1) { J.src = a.in[9] + (size_t)i * 2816 * 1024; J.dst = (bf16_t*)(wb + OFF_D); J.K = 2816; J.Nd = 1024; J.ld = 1024; }
    else if (t == 2) { J.src = a.in[6] + (size_t)i * 1024 * 512; J.gain = a.in[4] + i * 1024; J.dst = (bf16_t*)(a.ws + WS_WMKV) + (size_t)i * 512 * 1024; J.Nd = 512; J.ld = 512; }
    else if (t == 3) {
        J.gain = a.in[2] + i * 1024; J.dst = (bf16_t*)(wb + OFF_IN);
        if (!odd) { J.src = a.in[10] + (size_t)j * 1024 * 1792; J.Nd = 1792; J.ld = 1792; }
        else { J.src = a.in[15] + (size_t)j * 1024 * 2596; J.Nd = 2816; J.ld = 2596; J.kind = 2; }
    }
    else if (t == 4) { J.src = (odd ? a.in[22] : a.in[14]) + (size_t)j * 1024 * 1024; J.dst = (bf16_t*)(wb + OFF_OUT); J.Nd = 1024; J.ld = 1024; }
    else if (odd) {
        if (t == 5) { J.src = a.in[18] + (size_t)j * 2048 * 256; J.dst = (bf16_t*)(wb + OFF_CK1); J.K = 2048; J.Nd = 256; J.ld = 256; }
        else if (t == 6) { J.src = a.in[20] + (size_t)j * 2048 * 256; J.dst = (bf16_t*)(wb + OFF_CV1); J.K = 2048; J.Nd = 256; J.ld = 256; }
        else if (t == 7) { J.src = a.in[19] + (size_t)j * 256 * 64; J.dst = (bf16_t*)(wb + OFF_CK2); J.K = 256; J.Nd = 64; J.ld = 64; }
        else { J.src = a.in[21] + (size_t)j * 256 * 64; J.dst = (bf16_t*)(wb + OFF_CV2); J.K = 256; J.Nd = 64; J.ld = 64; }
    }
    return J;
}

__device__ __forceinline__ void p0_prologue(const Args& a, LAS unsigned char* lds, int tid, int lane, int wave) {
    const int gw = blockIdx.x * NWAVES + wave, NGW = gridDim.x * NWAVES;
    const int gtid = blockIdx.x * NTHREADS + tid, NGT = gridDim.x * NTHREADS;
    unsigned char* ws = a.ws;
    {
        LAS float* scr = (LAS float*)lds + wave * (64 * 33);
        int jidx = 0, jstart = 0; Job J = job_get(a, 0); int nitems = (J.K / 64) * (J.Nd / 32);
        for (int it = gw; ; it += NGW) {
            while (jidx < 36 && it >= jstart + nitems) { jstart += nitems; ++jidx; if (jidx < 36) { J = job_get(a, jidx); nitems = (J.K / 64) * (J.Nd / 32); } }
            if (jidx >= 36) break;
            const int r = it - jstart, ng = J.Nd / 32, kb = r / ng, g32 = r % ng;
            const float* src = J.src; int col0 = g32 * 32, nvalid = 32;
            if (J.kind == 1) { const int pn = g32 >> 3, w = g32 & 7; src = (w >> 2) ? J.srcB : J.src; col0 = pn * 128 + (w & 3) * 32; }
            else if (J.kind == 2) { const int pn = g32 >> 3, w = g32 & 7;
                if (pn <= 9) { const int base = pn < 9 ? pn * 256 : 2340; col0 = base + (w & 3) * 64 + (w >> 2) * 32; }
                else if (w == 0) { col0 = 2304; } else if (w == 1) { col0 = 2336; nvalid = 4; } else { col0 = 0; nvalid = 0; } }
            cvt_item(src, J.ld, col0, nvalid, J.gain, J.dst, J.K, g32 * 32, kb * 64, scr, lane);
        }
    }
    {
        const float* x = a.in[0]; bf16_t* xb = (bf16_t*)(ws + WS_XB); float* ssq = (float*)(ws + WS_SSQ);
        for (int row = gw; row < MTOK; row += 2 * NGW) {
            const bool has2 = row + NGW < MTOK; const int row2 = has2 ? row + NGW : row;
            const GAS f32x4* xr = (const GAS f32x4*)(x + (size_t)row * DM) + lane; const GAS f32x4* xr2 = (const GAS f32x4*)(x + (size_t)row2 * DM) + lane;
            f32x4 v[4], w[4]; float s = 0.f, s2 = 0.f;
#pragma unroll
            for (int j = 0; j < 4; ++j) { v[j] = xr[64 * j]; w[j] = xr2[64 * j]; }
#pragma unroll
            for (int j = 0; j < 4; ++j) { s += pg8::sumsq4(v[j]); s2 += pg8::sumsq4(w[j]); }
            s = wave_sum(s); s2 = wave_sum(s2);
            GAS u32x2* o8 = (GAS u32x2*)(xb + (size_t)row * DM) + lane; GAS u32x2* o82 = (GAS u32x2*)(xb + (size_t)row2 * DM) + lane;
#pragma unroll
            for (int j = 0; j < 4; ++j) { u32x2 a_; a_.x = cvt_pk_bf16(v[j][0], v[j][1]); a_.y = cvt_pk_bf16(v[j][2], v[j][3]); o8[64 * j] = a_;
                                          u32x2 b_; b_.x = cvt_pk_bf16(w[j][0], w[j][1]); b_.y = cvt_pk_bf16(w[j][2], w[j][3]); if (has2) o82[64 * j] = b_; }
            if (lane < 16) { ((GAS float*)ssq)[(size_t)row * 16 + lane] = (lane == 0) ? s : 0.f; if (has2) ((GAS float*)ssq)[(size_t)row2 * 16 + lane] = (lane == 0) ? s2 : 0.f; }
        }
    }
    {
        const float* mem = a.in[1]; bf16_t* mb = (bf16_t*)(ws + WS_MEMB); float* mr = (float*)(ws + WS_MISC + OFF_MEMRINV);
        for (int row = gw; row < NB * MEMLEN; row += NGW) {
            const f32x4* xr = (const f32x4*)(mem + (size_t)row * DM) + lane; f32x4 v[4]; float s = 0.f;
#pragma unroll
            for (int j = 0; j < 4; ++j) { v[j] = xr[64 * j]; s += pg8::sumsq4(v[j]); }
            s = wave_sum(s);
            u32x2* o8 = (u32x2*)(mb + (size_t)row * DM) + lane;
#pragma unroll
            for (int j = 0; j < 4; ++j) { u32x2 w; w.x = cvt_pk_bf16(v[j][0], v[j][1]); w.y = cvt_pk_bf16(v[j][2], v[j][3]); o8[64 * j] = w; }
            if (lane == 0) mr[row] = __builtin_amdgcn_rsqf(s * (1.0f / 1024.0f) + pg8::NORM_EPS);
        }
    }
    {
        float* rp = (float*)(ws + WS_ROPE);
        for (int e = gtid; e < SEQ * 32; e += NGT) {
            const int pos = e >> 5, j = e & 31;
            double inv = 1.0; for (int q = 0; q < j; ++q) inv *= 0.7498942093324559;
            const float ang = (float)pos * (float)inv;
            const double rev = (double)ang * 0.15915494309189535; const float fr = (float)(rev - __builtin_floor(rev));
            rp[2 * e] = __builtin_amdgcn_cosf(fr); rp[2 * e + 1] = __builtin_amdgcn_sinf(fr);
        }
    }
    {
        for (int e = gtid; e < 2 * 12 * 128 * 128 / 4; e += NGT) {
            const int j = e / (12 * 128 * 128 / 4), r = e % (12 * 128 * 128 / 4); const int t = (r >> 5) & 127, s0 = (r & 31) * 4;
            const f32x4 w = *(const GAS f32x4*)(a.in[12] + (size_t)j * 12 * 128 * 128 + (size_t)r * 4);
            u32x2 o; o.x = cvt_pk_bf16(s0 <= t ? w[0] : 0.f, s0 + 1 <= t ? w[1] : 0.f); o.y = cvt_pk_bf16(s0 + 2 <= t ? w[2] : 0.f, s0 + 3 <= t ? w[3] : 0.f);
            *(GAS u32x2*)((bf16_t*)(ws + WS_W + (size_t)(2 * j) * W_STRIDE + OFF_WSB) + (size_t)r * 4) = o;
        }
    }
    {
        float* bp = (float*)(ws + WS_MISC + OFF_BIAS1P);
        for (int task = gw; task < 256; task += NGW) {
            const int ng = task & 3, ks = (task >> 2) & 15, which = (task >> 6) & 1, jl = task >> 7;
            const float* pe = a.in[which ? 17 : 16] + (size_t)jl * 2048; const float* w1 = a.in[which ? 20 : 18] + (size_t)jl * 2048 * 256;
            const int n = ng * 64 + lane; float s = 0.f;
#pragma unroll 1
            for (int kb = ks * 128; kb < ks * 128 + 128; kb += 32) {
                float wv[32], pv[32];
#pragma unroll
                for (int i = 0; i < 32; ++i) { wv[i] = ((const GAS float*)w1)[(size_t)(kb + i) * 256 + n]; pv[i] = ((const GAS float*)pe)[kb + i]; }
#pragma unroll
                for (int i = 0; i < 32; ++i) s += pv[i] * wv[i];
            }
            bp[((jl * 2 + which) * 16 + ks) * 256 + n] = s;
        }
    }
}

typedef short v4i16s_t __attribute__((ext_vector_type(4)));
__device__ __forceinline__ s16x4 vtr_s(const LAS bf16_t* p) { return __builtin_bit_cast(s16x4, __builtin_amdgcn_ds_read_tr16_b64_v4i16((LAS v4i16s_t*)p)); }
__device__ __forceinline__ void spatial_phase(LAS unsigned char* lds, const bf16_t* U, const bf16_t* V, const float* vssq, const float* vgain, const float* bsp, const bf16_t* Wsb, bf16_t* cat,
                                              int tid, int lane, int wave) {
    LAS bf16_t* vS = (LAS bf16_t*)lds;
    LAS float* rv = (LAS float*)(lds + 128 * 272 * 2);
    const int lr = lane & 15, q = lane >> 4;
    for (int unit = blockIdx.x; unit < MTOK / 128; unit += gridDim.x) {
        const int r0 = unit * 128;
        __syncthreads();
        if (tid < 128) { const GAS float* p = (const GAS float*)vssq + (size_t)(r0 + tid) * 24; float s = 0.f;
#pragma unroll
            for (int i = 0; i < 24; ++i) s += p[i];
            rv[tid] = __builtin_amdgcn_rsqf(s * (1.0f / 768.0f) + pg8::NORM_EPS); }
#pragma unroll 1
        for (int g4 = 0; g4 < 3; ++g4) {
            __syncthreads();
#pragma unroll
            for (int i = 0; i < 8; ++i) {
                const int e = tid + NTHREADS * i, s = e >> 5, dc = e & 31;
                const u32x4 raw = *(const GAS u32x4*)(V + (size_t)(r0 + s) * 768 + g4 * 256 + dc * 8);
                const float rs = rv[s];
                const f32x4 g0 = *(const GAS f32x4*)(vgain + g4 * 256 + dc * 8), g1 = *(const GAS f32x4*)(vgain + g4 * 256 + dc * 8 + 4);
                u32x4 o;
                o.x = cvt_pk_bf16(__uint_as_float(raw.x << 16) * rs * g0[0], __uint_as_float(raw.x & 0xffff0000u) * rs * g0[1]);
                o.y = cvt_pk_bf16(__uint_as_float(raw.y << 16) * rs * g0[2], __uint_as_float(raw.y & 0xffff0000u) * rs * g0[3]);
                o.z = cvt_pk_bf16(__uint_as_float(raw.z << 16) * rs * g1[0], __uint_as_float(raw.z & 0xffff0000u) * rs * g1[1]);
                o.w = cvt_pk_bf16(__uint_as_float(raw.w << 16) * rs * g1[2], __uint_as_float(raw.w & 0xffff0000u) * rs * g1[3]);
                *(LAS u32x4*)(vS + s * 272 + dc * 8) = o;
            }
            __syncthreads();
            const int t = 16 * wave + lr, ksmax = (16 * wave + 15) >> 5;
#pragma unroll 1
            for (int gl = 0; gl < 4; ++gl) {
                const int g = g4 * 4 + gl;
                f32x4 acc[4];
#pragma unroll
                for (int dt = 0; dt < 4; ++dt) acc[dt] = (f32x4){0.f, 0.f, 0.f, 0.f};
                const int row = r0 + t;
                u32x2 uu4[4];
#pragma unroll
                for (int dt = 0; dt < 4; ++dt) uu4[dt] = *(const GAS u32x2*)(U + (size_t)row * 768 + g * 64 + 16 * dt + 4 * q);
                const float bias = ((const GAS float*)bsp)[g * 128 + t];
                for (int ks = 0; ks <= ksmax; ++ks) {
                    const GAS bf16_t* wp = (const GAS bf16_t*)Wsb + ((size_t)(g * 128 + t) * 128 + 32 * ks + 4 * q);
                    const bf16x8 bfr = mk8(*(const GAS s16x4*)wp, *(const GAS s16x4*)(wp + 16));
#pragma unroll
                    for (int dt = 0; dt < 4; ++dt) {
                        const LAS bf16_t* vp = vS + (32 * ks + 4 * q + (lr >> 2)) * 272 + gl * 64 + 16 * dt + 4 * (lr & 3);
                        const bf16x8 afr = mk8(vtr_s(vp), vtr_s(vp + 16 * 272));
                        acc[dt] = MFMA16(afr, bfr, acc[dt]);
                    }
                }
#pragma unroll
                for (int dt = 0; dt < 4; ++dt) {
                    const int d0 = 16 * dt + 4 * q;
                    const u32x2 uu = uu4[dt];
                    const float o0 = bf2f((unsigned short)(uu.x & 0xffffu)) * (acc[dt][0] + bias), o1 = bf2f((unsigned short)(uu.x >> 16)) * (acc[dt][1] + bias);
                    const float o2 = bf2f((unsigned short)(uu.y & 0xffffu)) * (acc[dt][2] + bias), o3 = bf2f((unsigned short)(uu.y >> 16)) * (acc[dt][3] + bias);
                    u32x2 w; w.x = cvt_pk_bf16(o0, o1); w.y = cvt_pk_bf16(o2, o3);
                    *(GAS u32x2*)(cat + (size_t)row * 1024 + g * 64 + d0) = w;
                }
            }
        }
    }
}

__device__ __forceinline__ void memattn_phase(LAS unsigned char* lds, const bf16_t* MQ, const bf16_t* memKV, int layer, bf16_t* cat, int tid, int lane, int wave, int u0, int ustride) {
    LAS bf16_t* Kl = (LAS bf16_t*)lds;
    LAS bf16_t* vT = (LAS bf16_t*)(lds + 256 * 72 * 2);
    const int lr = lane & 15, q = lane >> 4;
    for (int unit = u0; unit < 256; unit += ustride) {
        const int bh = unit >> 3, b = bh >> 2, h = bh & 3, chunk = unit & 7;
        __syncthreads();
#pragma unroll
        for (int i = 0; i < 4; ++i) {
            const int e = tid + NTHREADS * i, m = e >> 3, dc = e & 7;
            const bf16_t* src = memKV + (size_t)(b * 256 + m) * 2048 + layer * 512 + h * 64 + dc * 8;
            *(LAS u32x4*)(Kl + m * 72 + dc * 8) = *(const u32x4*)src;
            const u32x4 rv = *(const GAS u32x4*)(src + 256);
#pragma unroll
            for (int jj = 0; jj < 4; ++jj) { vT[(dc * 8 + 2 * jj) * 264 + m] = (unsigned short)(rv[jj] & 0xffffu); vT[(dc * 8 + 2 * jj + 1) * 264 + m] = (unsigned short)(rv[jj] >> 16); }
        }
        __syncthreads();
        for (int sub = 0; sub < 8; ++sub) {
            const int row = b * SEQ + chunk * 1024 + sub * 128 + 16 * wave + lr;
            bf16x8 qf[2];
#pragma unroll
            for (int ks = 0; ks < 2; ++ks) qf[ks] = *(const GAS bf16x8*)(MQ + (size_t)row * 256 + h * 64 + 32 * ks + 8 * q);
            f32x4 s[16];
#pragma unroll
            for (int mt = 0; mt < 16; ++mt) {
                s[mt] = (f32x4){0.f, 0.f, 0.f, 0.f};
#pragma unroll
                for (int ks = 0; ks < 2; ++ks) { const bf16x8 kf = *(const LAS bf16x8*)(Kl + (16 * mt + lr) * 72 + 32 * ks + 8 * q); s[mt] = MFMA16(kf, qf[ks], s[mt]); }
            }
            float mx = -1e30f;
#pragma unroll
            for (int mt = 0; mt < 16; ++mt) mx = fmaxf(mx, fmaxf(fmaxf(s[mt][0], s[mt][1]), fmaxf(s[mt][2], s[mt][3])));
            mx = pg8::xmax16(mx); mx = pg8::xmax32(mx);
            float ls = 0.f;
#pragma unroll
            for (int mt = 0; mt < 16; ++mt)
#pragma unroll
                for (int i = 0; i < 4; ++i) { const float p = __builtin_amdgcn_exp2f(s[mt][i] - mx); s[mt][i] = p; ls += p; }
            ls = pg8::xsum16(ls); ls = pg8::xsum32(ls);
            f32x4 acc[4];
#pragma unroll
            for (int dt = 0; dt < 4; ++dt) acc[dt] = (f32x4){0.f, 0.f, 0.f, 0.f};
#pragma unroll
            for (int kk = 0; kk < 8; ++kk) {
                const u32x4 pw = pg8::pack8(s[2 * kk], s[2 * kk + 1]); const bf16x8 pb = __builtin_bit_cast(bf16x8, pw);
#pragma unroll
                for (int dt = 0; dt < 4; ++dt) {
                    const LAS bf16_t* vp = vT + (16 * dt + lr) * 264 + 32 * kk + 4 * q;
                    const bf16x8 vf = mk8(*(const LAS s16x4*)vp, *(const LAS s16x4*)(vp + 16));
                    acc[dt] = MFMA16(vf, pb, acc[dt]);
                }
            }
            const float inv = __builtin_amdgcn_rcpf(ls);
#pragma unroll
            for (int dt = 0; dt < 4; ++dt) {
                u32x2 w; w.x = cvt_pk_bf16(acc[dt][0] * inv, acc[dt][1] * inv); w.y = cvt_pk_bf16(acc[dt][2] * inv, acc[dt][3] * inv);
                *(GAS u32x2*)(cat + (size_t)row * 1024 + 768 + h * 64 + 16 * dt + 4 * q) = w;
            }
        }
    }
}

__device__ __forceinline__ void cmp2_phase(const bf16_t* Hc, const bf16_t* w2k, const bf16_t* w2v, bf16_t* kcc, bf16_t* vcc, int lane, int wave) {
    const int gw = blockIdx.x * NWAVES + wave, NGW = gridDim.x * NWAVES; const int lr = lane & 15, q = lane >> 4;
    for (int unit = gw; unit < 2048; unit += NGW) {
        const int which = unit >> 10, R0 = (unit & 1023) * 16;
        const bf16_t* H = Hc + (size_t)which * 16384 * 256; const bf16_t* w2 = which ? w2v : w2k; bf16_t* dst = which ? vcc : kcc;
        f32x4 acc[4];
#pragma unroll
        for (int nt = 0; nt < 4; ++nt) acc[nt] = (f32x4){0.f, 0.f, 0.f, 0.f};
#pragma unroll
        for (int ks = 0; ks < 8; ++ks) {
            const bf16x8 bfr = *(const GAS bf16x8*)(H + (size_t)(R0 + lr) * 256 + 32 * ks + 8 * q);
#pragma unroll
            for (int nt = 0; nt < 4; ++nt) { const bf16x8 afr = *(const GAS bf16x8*)(w2 + (size_t)(16 * nt + lr) * 256 + 32 * ks + 8 * q); acc[nt] = MFMA16(afr, bfr, acc[nt]); }
        }
#pragma unroll
        for (int nt = 0; nt < 4; ++nt) { u32x2 w; w.x = cvt_pk_bf16(acc[nt][0], acc[nt][1]); w.y = cvt_pk_bf16(acc[nt][2], acc[nt][3]); *(GAS u32x2*)(dst + (size_t)(R0 + lr) * 64 + 16 * nt + 4 * q) = w; }
    }
}

typedef short v4i16_t __attribute__((ext_vector_type(4)));
__device__ __forceinline__ s16x4 vtr(const LAS bf16_t* p) { return __builtin_bit_cast(s16x4, __builtin_amdgcn_ds_read_tr16_b64_v4i16((LAS v4i16_t*)p)); }
constexpr float RESC_THR = 8.0f;
template <bool MASKED>
__device__ __forceinline__ void qk_softmax(const LAS bf16_t* Kt, const bf16x8 (&qf)[3][2], float (&m)[3], f32x4 (&lacc)[3], f32x4 (&acc)[3][4], unsigned& started,
                                           bool act, int hi, int lo, int lr, int q, bf16x8 (&pb)[3][2]) {
    const LAS bf16_t* kbase = Kt + lr * 72 + 8 * q;
    const int hq = hi - 4 * q, lq = lo - 4 * q;
    f32x4 s[3][4];
    {
        f32x4 c0[3];
#pragma unroll
        for (int r = 0; r < 3; ++r) { const float nm = act ? -m[r] : -1e30f; c0[r] = (f32x4){nm, nm, nm, nm}; }
        bf16x8 kf[2][2];
        kf[0][0] = *(const LAS bf16x8*)(kbase); kf[0][1] = *(const LAS bf16x8*)(kbase + 32);
#pragma unroll
        for (int mt = 0; mt < 4; ++mt) {
            if (mt < 3) { kf[(mt + 1) & 1][0] = *(const LAS bf16x8*)(kbase + 16 * (mt + 1) * 72); kf[(mt + 1) & 1][1] = *(const LAS bf16x8*)(kbase + 16 * (mt + 1) * 72 + 32); }
            __builtin_amdgcn_sched_barrier(0);
#pragma unroll
            for (int r = 0; r < 3; ++r) { s[r][mt] = MFMA16(kf[mt & 1][0], qf[r][0], c0[r]); s[r][mt] = MFMA16(kf[mt & 1][1], qf[r][1], s[r][mt]); }
            __builtin_amdgcn_sched_barrier(0);
        }
    }
    float mx[3];
#pragma unroll
    for (int r = 0; r < 3; ++r) {
        if (MASKED) {
#pragma unroll
            for (int mt = 0; mt < 4; ++mt)
#pragma unroll
                for (int i = 0; i < 4; ++i) { s[r][mt][i] = ((16 * mt + i) <= hq && (16 * mt + i) > lq) ? s[r][mt][i] : -1e30f; }
        }
        mx[r] = fmaxf(fmaxf(fmaxf(fmaxf(fmaxf(s[r][0][0], s[r][0][1]), s[r][0][2]), fmaxf(fmaxf(s[r][0][3], s[r][1][0]), s[r][1][1])), fmaxf(fmaxf(s[r][1][2], s[r][1][3]), s[r][2][0])), fmaxf(fmaxf(fmaxf(fmaxf(s[r][2][1], s[r][2][2]), s[r][2][3]), fmaxf(fmaxf(s[r][3][0], s[r][3][1]), s[r][3][2])), s[r][3][3]));
    }
#pragma unroll
    for (int r = 0; r < 3; ++r) mx[r] = pg8::xmax16(mx[r]);
#pragma unroll
    for (int r = 0; r < 3; ++r) mx[r] = pg8::xmax32(mx[r]);
    bool need[3]; bool anyneed = false;
#pragma unroll
    for (int r = 0; r < 3; ++r) { const bool st = ((started >> r) & 1u) != 0u; need[r] = (mx[r] > -1e29f) && (!st || mx[r] > RESC_THR); anyneed = anyneed || need[r]; }
    if (__builtin_amdgcn_ballot_w64(anyneed) != 0ull) {
#pragma unroll
        for (int r = 0; r < 3; ++r) {
            const bool st = ((started >> r) & 1u) != 0u;
            const float dl = need[r] ? mx[r] : 0.f;
            const float alpha = need[r] ? (st ? __builtin_amdgcn_exp2f(-dl) : 0.f) : 1.f;
            m[r] += dl;
#pragma unroll
            for (int mt = 0; mt < 4; ++mt) s[r][mt] = s[r][mt] - dl;
            lacc[r] = lacc[r] * alpha;
#pragma unroll
            for (int dt = 0; dt < 4; ++dt) acc[r][dt] = acc[r][dt] * alpha;
            if (need[r]) started |= (1u << r);
        }
    }
#pragma unroll
    for (int r = 0; r < 3; ++r)
#pragma unroll
        for (int mt = 0; mt < 4; ++mt)
#pragma unroll
            for (int i = 0; i < 4; ++i) s[r][mt][i] = __builtin_amdgcn_exp2f(s[r][mt][i]);
#pragma unroll
    for (int r = 0; r < 3; ++r) {
        pb[r][0] = __builtin_bit_cast(bf16x8, pg8::pack8(s[r][0], s[r][1]));
        pb[r][1] = __builtin_bit_cast(bf16x8, pg8::pack8(s[r][2], s[r][3]));
    }
    __builtin_amdgcn_sched_barrier(0);
}
__device__ __forceinline__ void pv_part(const LAS bf16_t* Vt, const bf16x8 (&pb)[3][2], f32x4 (&lacc)[3], f32x4 (&acc)[3][4], int lr, int q) {
    const LAS bf16_t* vbase = Vt + (4 * q + (lr >> 2)) * 72 + 4 * (lr & 3);
    const bf16x8 ones = (bf16x8){0x3F80, 0x3F80, 0x3F80, 0x3F80, 0x3F80, 0x3F80, 0x3F80, 0x3F80};
    s16x4 vv[2][2];
    vv[0][0] = vtr(vbase); vv[0][1] = vtr(vbase + 16 * 72);
#pragma unroll
    for (int it = 0; it < 8; ++it) {
        const int kk = it >> 2, dt = it & 3;
        if (it < 7) { const int kk2 = (it + 1) >> 2, dt2 = (it + 1) & 3; vv[(it + 1) & 1][0] = vtr(vbase + (32 * kk2) * 72 + 16 * dt2); vv[(it + 1) & 1][1] = vtr(vbase + (32 * kk2 + 16) * 72 + 16 * dt2); }
        __builtin_amdgcn_sched_barrier(0);
        const bf16x8 vf = mk8(vv[it & 1][0], vv[it & 1][1]);
#pragma unroll
        for (int r = 0; r < 3; ++r) acc[r][dt] = MFMA16(vf, pb[r][kk], acc[r][dt]);
        if (dt == 0) {
#pragma unroll
            for (int r = 0; r < 3; ++r) lacc[r] = MFMA16(ones, pb[r][kk], lacc[r]);
        }
        __builtin_amdgcn_sched_barrier(0);
    }
}

__device__ __forceinline__ void tile_importance(const LAS bf16_t* Kt, const bf16x8 (&qf)[3][2], const float (&m)[3], const float (&invl)[3], int hi, LAS float* imp, int tt, int lr, int q) {
    const int hq = hi - 4 * q;
    f32x4 P[4];
#pragma unroll
    for (int mt = 0; mt < 4; ++mt) P[mt] = (f32x4){0.f, 0.f, 0.f, 0.f};
#pragma unroll
    for (int r = 0; r < 3; ++r) {
        const f32x4 c0 = (f32x4){-m[r], -m[r], -m[r], -m[r]};
#pragma unroll
        for (int mt = 0; mt < 4; ++mt) {
            f32x4 s = c0;
#pragma unroll
            for (int ks = 0; ks < 2; ++ks) { const bf16x8 kf = *(const LAS bf16x8*)(Kt + (16 * mt + lr) * 72 + 32 * ks + 8 * q); s = MFMA16(kf, qf[r][ks], s); }
#pragma unroll
            for (int i = 0; i < 4; ++i) { const float p = ((16 * mt + i) <= hq) ? __builtin_amdgcn_exp2f(s[i]) * invl[r] : 0.f; P[mt][i] += p; }
        }
    }
#pragma unroll
    for (int mt = 0; mt < 4; ++mt) {
        const int n = 16 * tt + 4 * mt + q;
        const float own = (P[mt][0] + P[mt][1]) + (P[mt][2] + 0.5f * P[mt][3]), sp = 0.5f * P[mt][3];
        __hip_atomic_fetch_add(&imp[lr * 128 + n], own, __ATOMIC_RELAXED, __HIP_MEMORY_SCOPE_WORKGROUP);
        if (n + 1 < 128) __hip_atomic_fetch_add(&imp[lr * 128 + n + 1], sp, __ATOMIC_RELAXED, __HIP_MEMORY_SCOPE_WORKGROUP);
    }
}

__device__ __forceinline__ void sel_group(const LAS bf16_t* Kt, const LAS bf16_t* Vt, LAS float* S, const bf16x8 qB0, const bf16x8 qB1, int jc, int rc, bool valid, bool masked, int tw64, int lr, int q) {
    LAS float* Srow = S + (jc * 3 + rc) * 68;
    const float mref = Srow[65]; const bool st = Srow[66] != 0.f;
    f32x4 acc[4];
#pragma unroll
    for (int dt = 0; dt < 4; ++dt) acc[dt] = *(const LAS f32x4*)(Srow + 16 * dt + 4 * q);
    float lc = Srow[64];
    const float nm = valid ? -mref : -1e30f;
    const f32x4 c0 = (f32x4){nm, nm, nm, nm};
    const LAS bf16_t* kbase = Kt + lr * 72 + 8 * q;
    f32x4 s[4];
    {
        bf16x8 kf[2][2];
        kf[0][0] = *(const LAS bf16x8*)(kbase); kf[0][1] = *(const LAS bf16x8*)(kbase + 32);
#pragma unroll
        for (int mt = 0; mt < 4; ++mt) {
            if (mt < 3) { kf[(mt + 1) & 1][0] = *(const LAS bf16x8*)(kbase + 16 * (mt + 1) * 72); kf[(mt + 1) & 1][1] = *(const LAS bf16x8*)(kbase + 16 * (mt + 1) * 72 + 32); }
            __builtin_amdgcn_sched_barrier(0);
            __builtin_amdgcn_s_setprio(1); s[mt] = MFMA16(kf[mt & 1][0], qB0, c0); s[mt] = MFMA16(kf[mt & 1][1], qB1, s[mt]); __builtin_amdgcn_s_setprio(0);
            __builtin_amdgcn_sched_barrier(0);
        }
    }
    if (masked) {
        const int hq = tw64 + jc - 4 * q;
#pragma unroll
        for (int mt = 0; mt < 4; ++mt)
#pragma unroll
            for (int i = 0; i < 4; ++i) s[mt][i] = ((16 * mt + i) <= hq) ? s[mt][i] : -1e30f;
    }
    float mx = fmaxf(fmaxf(fmaxf(fmaxf(fmaxf(s[0][0], s[0][1]), s[0][2]), fmaxf(fmaxf(s[0][3], s[1][0]), s[1][1])), fmaxf(fmaxf(s[1][2], s[1][3]), s[2][0])), fmaxf(fmaxf(fmaxf(fmaxf(s[2][1], s[2][2]), s[2][3]), fmaxf(fmaxf(s[3][0], s[3][1]), s[3][2])), s[3][3]));
    mx = pg8::xmax16(mx); mx = pg8::xmax32(mx);
    const bool need = valid && (mx > -1e29f) && (!st || mx > RESC_THR);
    const bool anyneed = __builtin_amdgcn_ballot_w64(need) != 0ull;
    float alpha = 1.f;
    if (anyneed) {
        const float dl = need ? mx : 0.f;
        alpha = need ? (st ? __builtin_amdgcn_exp2f(-dl) : 0.f) : 1.f;
#pragma unroll
        for (int mt = 0; mt < 4; ++mt) s[mt] = s[mt] - dl;
        if (need && q == 0) { Srow[65] = mref + dl; Srow[66] = 1.f; }
    }
#pragma unroll
    for (int mt = 0; mt < 4; ++mt)
#pragma unroll
        for (int i = 0; i < 4; ++i) s[mt][i] = __builtin_amdgcn_exp2f(s[mt][i]);
    bf16x8 pb[2];
    pb[0] = __builtin_bit_cast(bf16x8, pg8::pack8(s[0], s[1]));
    pb[1] = __builtin_bit_cast(bf16x8, pg8::pack8(s[2], s[3]));
    if (anyneed) {
#pragma unroll
        for (int dt = 0; dt < 4; ++dt) acc[dt] = acc[dt] * alpha;
        lc *= alpha;
    }
    f32x4 ls = (f32x4){0.f, 0.f, 0.f, 0.f};
    {
        const LAS bf16_t* vbase = Vt + (4 * q + (lr >> 2)) * 72 + 4 * (lr & 3);
        const bf16x8 ones = (bf16x8){0x3F80, 0x3F80, 0x3F80, 0x3F80, 0x3F80, 0x3F80, 0x3F80, 0x3F80};
        s16x4 vv[2][2];
        vv[0][0] = vtr(vbase); vv[0][1] = vtr(vbase + 16 * 72);
#pragma unroll
        for (int it = 0; it < 8; ++it) {
            const int kk = it >> 2, dt = it & 3;
            if (it < 7) { const int kk2 = (it + 1) >> 2, dt2 = (it + 1) & 3; vv[(it + 1) & 1][0] = vtr(vbase + (32 * kk2) * 72 + 16 * dt2); vv[(it + 1) & 1][1] = vtr(vbase + (32 * kk2 + 16) * 72 + 16 * dt2); }
            __builtin_amdgcn_sched_barrier(0);
            const bf16x8 vf = mk8(vv[it & 1][0], vv[it & 1][1]);
            __builtin_amdgcn_s_setprio(1); acc[dt] = MFMA16(vf, pb[kk], acc[dt]);
            if (dt == 0) ls = MFMA16(ones, pb[kk], ls);
            __builtin_amdgcn_s_setprio(0);
            __builtin_amdgcn_sched_barrier(0);
        }
    }
    if (valid) {
#pragma unroll
        for (int dt = 0; dt < 4; ++dt) *(LAS f32x4*)(Srow + 16 * dt + 4 * q) = acc[dt];
        if (q == 0) Srow[64] = lc + ls[0];
    }
}

struct KVRegs { u32x4 k, v; };
__device__ __forceinline__ void kv_fetch(KVRegs& R, const bf16_t* gK, const bf16_t* gV, int tid, bool withv) {
    R.k = *(const GAS u32x4*)(gK + tid * 8);
    if (withv) R.v = *(const GAS u32x4*)(gV + tid * 8);
}
__device__ __forceinline__ void kv_commit(const KVRegs& R, LAS bf16_t* Kt, LAS bf16_t* Vt, int tid, bool withv) {
    const int key = tid >> 3, dc = tid & 7;
    *(LAS u32x4*)(Kt + key * 72 + dc * 8) = R.k;
    if (withv) *(LAS u32x4*)(Vt + key * 72 + dc * 8) = R.v;
}

__device__ __forceinline__ void nsa_phase(LAS unsigned char* lds, const bf16_t* Q, const bf16_t* KVG, size_t kvg_stride, const bf16_t* kcc, const bf16_t* vcc, const float* G, bf16_t* cat,
                                          int tid, int lane, int wave) {
    LAS bf16_t* Kb0 = (LAS bf16_t*)lds;
    LAS bf16_t* Vb0 = (LAS bf16_t*)(lds + 2 * 64 * 72 * 2);
    LAS float* imp = (LAS float*)(lds + 5 * 64 * 72 * 2) + wave * 3264;
    LAS float* Ssel = imp;
    LAS unsigned* selw = (LAS unsigned*)(lds + 5 * 64 * 72 * 2 + NWAVES * 3264 * 4) + wave * 64;
    LAS unsigned* slist = (LAS unsigned*)(lds + 5 * 64 * 72 * 2 + NWAVES * 3264 * 4 + NWAVES * 256) + wave * 16;
    const bf16_t* KS = KVG + 2 * kvg_stride; (void)KS;
    for (int u = blockIdx.x; u < 2048; u += gridDim.x) {
        const int rnd = u >> 8, cc = u & 255, xq = cc & 7, bg = 4 * rnd + (xq >> 1), ii = (xq & 1) * 32 + (cc >> 3), iq = (rnd & 1) ? 63 - ii : ii;
        const int b = bg >> 2, g = bg & 3, t0 = 128 * iq;
        int lane_u; asm volatile("v_mbcnt_lo_u32_b32 %0, -1, 0\n\tv_mbcnt_hi_u32_b32 %0, -1, %0" : "=&v"(lane_u));
        const int lr = lane_u & 15, q = lane_u >> 4;
        const int t = t0 + 16 * wave + lr; const size_t rowu = (size_t)b * SEQ + t0; const unsigned tl = (unsigned)(16 * wave + lr);
        const bf16_t* Qp = Q + rowu * 768 + 3 * g * 64; const float* Gp = G + rowu * 36 + 9 * g; bf16_t* catp = cat + rowu * 1024 + 3 * g * 64;
        bf16x8 qf[3][2];
#pragma unroll
        for (int r = 0; r < 3; ++r)
#pragma unroll
            for (int ks = 0; ks < 2; ++ks) qf[r][ks] = *(const GAS bf16x8*)(Qp + (tl * 768u + (unsigned)(r * 64 + 32 * ks + 8 * q)));
        const int ntc = (8 * iq + 7 + 63) >> 6;
        const int cmaxv = (t - 31) >> 4;
#pragma unroll 1
        for (int br = 0; br < 3; ++br) {
            const bf16_t* gK; const bf16_t* gV; int nbeg, nend, hbase;
            if (br == 0) { gK = kcc + (size_t)bg * 512 * 64; gV = vcc + (size_t)bg * 512 * 64; nbeg = 0; nend = ntc; hbase = cmaxv; }
            else { gK = KVG + (size_t)(2 * br) * kvg_stride + (size_t)bg * SEQ * 64; gV = gK + kvg_stride; nbeg = (br == 2 && 2 * iq - 8 > 0) ? 2 * iq - 8 : 0; nend = 2 * iq + 2; hbase = t; }
            if (br == 1) {
                float zs_ = 0.f; asm volatile("" : "+v"(zs_));
                int lane_c = lane_u; asm volatile("" : "+v"(lane_c));
                const int lr = lane_c & 15, q = lane_c >> 4;
#pragma unroll
                for (int i = 0; i < 13; ++i) { const int e4 = lane_u + 64 * i; if (e4 < 816) *(LAS f32x4*)(Ssel + e4 * 4) = (f32x4){zs_, zs_, zs_, zs_}; }
                KVRegs R;
                __syncthreads();
                int tb = wave * 64 + lane_u; asm volatile("" : "+v"(tb));
                kv_fetch(R, gK + (size_t)nbeg * 4096, gV + (size_t)nbeg * 4096, tb, true);
                int kc_ = 0;
                const GAS bf16_t* Qw = (const GAS bf16_t*)(Qp + (size_t)(16 * wave) * 768);
                const unsigned w_own = selw[lr * 4 + q];
                for (int n = nbeg; n < nend; ++n) {
                    LAS bf16_t* Kt = Kb0 + kc_ * 64 * 72; LAS bf16_t* Vt = Vb0 + kc_ * 64 * 72;
                    kv_commit(R, Kt, Vt, tb, true);
                    const bool bitn = ((w_own >> (n & 31)) & 1u) != 0u;
                    const unsigned mask16 = (unsigned)((__builtin_amdgcn_ballot_w64(bitn) >> (16 * (n >> 5))) & 0xFFFFull);
                    const int ksel = __builtin_popcount(mask16);
                    const bool act = ((mask16 >> lr) & 1u) != 0u;
                    if (act && q == 0) slist[__builtin_popcount(mask16 & ((1u << lr) - 1u))] = (unsigned)lr;
                    asm volatile("s_waitcnt lgkmcnt(0)" ::: "memory");
                    int jcg[3], rcg[3]; bool vg[3]; bf16x8 qB[3][2]; unsigned sl[3];
#pragma unroll
                    for (int gi = 0; gi < 3; ++gi) sl[gi] = slist[((16 * gi + lr) * 43) >> 7];
#pragma unroll
                    for (int gi = 0; gi < 3; ++gi) {
                        const int cg = 16 * gi + lr, idx = (cg * 43) >> 7; rcg[gi] = cg - 3 * idx; vg[gi] = idx < ksel;
                        jcg[gi] = vg[gi] ? (int)sl[gi] : 0;
                        const GAS bf16_t* qg = Qw + (jcg[gi] * 768 + rcg[gi] * 64 + 8 * q);
                        qB[gi][0] = *(const GAS bf16x8*)qg; qB[gi][1] = *(const GAS bf16x8*)(qg + 32);
                    }
                    if (n + 1 < nend) kv_fetch(R, gK + (size_t)(n + 1) * 4096, gV + (size_t)(n + 1) * 4096, tb, true);
                    __syncthreads();
                    const int ng = (3 * ksel + 15) >> 4;
                    const bool msk = (n == ((t0 + 16 * wave) >> 6));
#pragma unroll
                    for (int gi = 0; gi < 3; ++gi)
                        if (gi < ng) sel_group(Kt, Vt, Ssel, qB[gi][0], qB[gi][1], jcg[gi], rcg[gi], vg[gi], msk, t0 + 16 * wave - 64 * n, lr, q);
                    kc_ ^= 1;
                }
                int lane_f = lane_u; asm volatile("" : "+v"(lane_f));
                const int lrf = lane_f & 15, qf_ = lane_f >> 4; const unsigned tlf_ = (unsigned)(16 * wave + lrf);
#pragma unroll
                for (int r = 0; r < 3; ++r) {
                    const float gt_ = ((const GAS float*)Gp)[tlf_ * 36u + (unsigned)(r * 3 + 1)];
                    const LAS float* Sr = Ssel + (lrf * 3 + r) * 68;
                    const float l1 = Sr[64]; const float sc_ = l1 > 0.f ? gt_ * __builtin_amdgcn_rcpf(l1) : 0.f;
#pragma unroll
                    for (int dt = 0; dt < 4; ++dt) {
                        f32x4 o = *(const LAS f32x4*)(Sr + 16 * dt + 4 * qf_) * sc_;
                        GAS u32x2* cp = (GAS u32x2*)(catp + (tlf_ * 1024u + (unsigned)(r * 64 + 16 * dt + 4 * qf_)));
                        const u32x2 old_ = *cp; o[0] += __uint_as_float(old_.x << 16); o[1] += __uint_as_float(old_.x & 0xffff0000u); o[2] += __uint_as_float(old_.y << 16); o[3] += __uint_as_float(old_.y & 0xffff0000u);
                        u32x2 w_; w_.x = cvt_pk_bf16(o[0], o[1]); w_.y = cvt_pk_bf16(o[2], o[3]); *cp = w_;
                    }
                }
                asm volatile("s_waitcnt lgkmcnt(0)" ::: "memory");
                continue;
            }
            float zf_ = 0.f; asm volatile("" : "+v"(zf_));
            float m[3]; f32x4 lacc[3]; f32x4 acc[3][4]; unsigned started = __float_as_uint(zf_);
#pragma unroll
            for (int r = 0; r < 3; ++r) { m[r] = zf_; lacc[r] = (f32x4){zf_, zf_, zf_, zf_};
#pragma unroll
                for (int dt = 0; dt < 4; ++dt) acc[r][dt] = (f32x4){zf_, zf_, zf_, zf_}; }
            KVRegs R;
            __syncthreads();
            int tb = wave * 64 + lane_u; asm volatile("" : "+v"(tb));
            kv_fetch(R, gK + (size_t)nbeg * 4096, gV + (size_t)nbeg * 4096, tb, true);
            int kc_ = 0;
            for (int n = nbeg; n < nend; ++n) {
                LAS bf16_t* Kt = Kb0 + kc_ * 64 * 72; LAS bf16_t* Vt = Vb0 + kc_ * 64 * 72;
                kv_commit(R, Kt, Vt, tb, true);
                if (n + 1 < nend) kv_fetch(R, gK + (size_t)(n + 1) * 4096, gV + (size_t)(n + 1) * 4096, tb, true);
                __syncthreads();
                const int hi = hbase - 64 * n, lo = (br == 2) ? t - 512 - 64 * n : -1;
                const bool act = hi >= 0 && lo < 63;
                if (__builtin_amdgcn_ballot_w64(act) != 0ull) {
                    bf16x8 pb[3][2];
                    if (__builtin_amdgcn_ballot_w64(act && (hi < 63 || lo >= 0)) != 0ull) qk_softmax<true>(Kt, qf, m, lacc, acc, started, act, hi, lo, lr, q, pb);
                    else qk_softmax<false>(Kt, qf, m, lacc, acc, started, act, hi, lo, lr, q, pb);
                    pv_part(Vt, pb, lacc, acc, lr, q);
                }
                kc_ ^= 1;
            }
            float invl[3];
#pragma unroll
            for (int r = 0; r < 3; ++r) { const float lt = lacc[r][0]; invl[r] = lt > 0.f ? __builtin_amdgcn_rcpf(lt) : 0.f; }
            if (br == 0) {
                int lane_k = lane_u; asm volatile("" : "+v"(lane_k));
                const int lr = lane_k & 15, q = lane_k >> 4;
#pragma unroll
                for (int i = 0; i < 8; ++i) *(LAS f32x4*)(imp + lane_k * 32 + i * 4) = (f32x4){zf_, zf_, zf_, zf_};
                asm volatile("s_waitcnt lgkmcnt(0)" ::: "memory");
                __syncthreads();
                int tk = wave * 64 + lane_k; asm volatile("" : "+v"(tk));
                u32x4 rk = *(const GAS u32x4*)(gK + tk * 8);
                for (int tt = 0; tt < ntc; ++tt) {
                    LAS bf16_t* Kt = Kb0 + (tt & 1) * 64 * 72;
                    *(LAS u32x4*)(Kt + (tk >> 3) * 72 + (tk & 7) * 8) = rk;
                    if (tt + 1 < ntc) rk = *(const GAS u32x4*)(gK + (size_t)(tt + 1) * 4096 + tk * 8);
                    __syncthreads();
                    const int hi = cmaxv - 64 * tt;
                    if (__builtin_amdgcn_ballot_w64(hi >= 0) != 0ull) tile_importance(Kt, qf, m, invl, hi, imp, tt, lr, q);
                }
                asm volatile("s_waitcnt lgkmcnt(0)" ::: "memory");
                const int cur = (t0 + 16 * wave) >> 6;
                unsigned word = 0u;
                if (cur <= 15) { if (q == 0) word = (1u << (cur + 1)) - 1u; }
                else {
                    unsigned v[32];
#pragma unroll
                    for (int i = 0; i < 8; ++i) { const f32x4 xv = *(const LAS f32x4*)(imp + lr * 128 + 32 * q + 4 * i);
#pragma unroll
                        for (int e = 0; e < 4; ++e) { const int j = 4 * i + e, n = 32 * q + j; const unsigned key = (__float_as_uint(xv[e]) & ~0x7Fu) | (unsigned)(127 - n); v[j] = (n < 1 || n > cur - 2) ? 0u : key; } }
                    for (int rd = 0; rd < 13; ++rd) {
                        unsigned best = v[0];
#pragma unroll
                        for (int j = 1; j < 32; ++j) best = best > v[j] ? best : v[j];
                        { const auto r1 = __builtin_amdgcn_permlane16_swap(best, best, false, false); best = r1[0] > r1[1] ? r1[0] : r1[1]; }
                        { const auto r2 = __builtin_amdgcn_permlane32_swap(best, best, false, false); best = r2[0] > r2[1] ? r2[0] : r2[1]; }
                        const int nw = 127 - (int)(best & 0x7Fu);
                        if ((nw >> 5) == q) word |= 1u << (nw & 31);
#pragma unroll
                        for (int j = 0; j < 32; ++j) v[j] = (v[j] == best) ? 0u : v[j];
                    }
                    if (q == 0) word |= 1u;
                    if ((cur >> 5) == q) word |= 1u << (cur & 31);
                    if (((cur - 1) >> 5) == q) word |= 1u << ((cur - 1) & 31);
                }
                selw[lr * 4 + q] = word;
                asm volatile("s_waitcnt lgkmcnt(0)" ::: "memory");
            }
            {
                int lane_f = lane_u; asm volatile("" : "+v"(lane_f));
                const int lr = lane_f & 15, q = lane_f >> 4; const unsigned tlf_ = (unsigned)(16 * wave + lr);
#pragma unroll
                for (int r = 0; r < 3; ++r) {
                    const float gt_ = ((const GAS float*)Gp)[tlf_ * 36u + (unsigned)(r * 3 + br)];
                    const float sc_ = gt_ * invl[r];
#pragma unroll
                    for (int dt = 0; dt < 4; ++dt) {
                        f32x4 o = acc[r][dt] * sc_;
                        GAS u32x2* cp = (GAS u32x2*)(catp + (tlf_ * 1024u + (unsigned)(r * 64 + 16 * dt + 4 * q)));
                        if (br > 0) { const u32x2 old_ = *cp; o[0] += __uint_as_float(old_.x << 16); o[1] += __uint_as_float(old_.x & 0xffff0000u); o[2] += __uint_as_float(old_.y << 16); o[3] += __uint_as_float(old_.y & 0xffff0000u); }
                        u32x2 w_; w_.x = cvt_pk_bf16(o[0], o[1]); w_.y = cvt_pk_bf16(o[2], o[3]); *cp = w_;
                    }
                }
                asm volatile("s_waitcnt lgkmcnt(0)" ::: "memory");
            }
        }
    }
}

__device__ __forceinline__ void final_norm_phase(float* x, const float* ssq, const float* gfin, int lane, int wave) {
    const int gw = blockIdx.x * NWAVES + wave, NGW = gridDim.x * NWAVES;
    f32x4 gv[4];
#pragma unroll
    for (int j = 0; j < 4; ++j) gv[j] = ((const f32x4*)gfin)[64 * j + lane];
    for (int row = gw; row < MTOK; row += 2 * NGW) {
        const bool has2 = row + NGW < MTOK; const int row2 = has2 ? row + NGW : row;
        const float rinv = pg8::row_rinv16(ssq, row), rinv2 = pg8::row_rinv16(ssq, row2);
        GAS f32x4* xr = (GAS f32x4*)(x + (size_t)row * DM) + lane; GAS f32x4* xr2 = (GAS f32x4*)(x + (size_t)row2 * DM) + lane;
        f32x4 v[4], w[4];
#pragma unroll
        for (int j = 0; j < 4; ++j) { v[j] = xr[64 * j]; w[j] = xr2[64 * j]; }
#pragma unroll
        for (int j = 0; j < 4; ++j) { xr[64 * j] = v[j] * rinv * gv[j]; if (has2) xr2[64 * j] = w[j] * rinv2 * gv[j]; }
    }
}

typedef unsigned v4u_unused_ __attribute__((ext_vector_type(4)));
#define XB_TMO      128
#define XB_XCNT(j)  (256  + 64 * (j))
#define XB_XSUB(j)  (1280 + 64 * (j))
#define XB_XGEN(j)  (2304 + 64 * (j))
#define XB_TOP      3328
#define XB_TOPGEN   3392
#define XCD_BAR_WORDS 3456
#define XB_SPIN_CAP (1u << 18)

__device__ __forceinline__ unsigned xb_ld(unsigned* p)              { return __hip_atomic_load(p, __ATOMIC_RELAXED, __HIP_MEMORY_SCOPE_AGENT); }
__device__ __forceinline__ unsigned xb_add(unsigned* p, unsigned v) { return __hip_atomic_fetch_add(p, v, __ATOMIC_RELAXED, __HIP_MEMORY_SCOPE_AGENT); }
__device__ __forceinline__ unsigned xb_xcc_id() { return (unsigned)__builtin_amdgcn_s_getreg((3 << 11) | 20) & 0xFu; }
#define XB_SPIN(cond, bar) do { unsigned _sp = 0; while (cond) { __builtin_amdgcn_s_sleep(1); \
    if ((++_sp & 255u) == 0u) { if (xb_ld(&(bar)[XB_TMO])) break; if (_sp > XB_SPIN_CAP) { atomicAdd(&(bar)[XB_TMO], 1u); break; } } } } while (0)

struct XcdBarrier {
    unsigned* bar; unsigned x;
    volatile LAS unsigned* st;
};

__device__ __forceinline__ XcdBarrier xcd_barrier_post(unsigned* bar, volatile LAS unsigned* st) {
    XcdBarrier b; b.bar = bar; b.x = xb_xcc_id(); b.st = st;
    if (threadIdx.x == 0) (void)xb_add(&bar[XB_XCNT(b.x)], 1u);
    return b;
}
__device__ __forceinline__ void xcd_barrier_complete(unsigned* bar, unsigned x, unsigned& nloc, unsigned& nx) {
    const unsigned G = gridDim.x * gridDim.y * gridDim.z;
    unsigned sum, cnt, mine, sp = 0u;
    for (;;) {
        sum = 0u; cnt = 0u; mine = 0u;
#pragma unroll
        for (unsigned j = 0; j < 16; ++j) { const unsigned c = xb_ld(&bar[XB_XCNT(j)]); sum += c; cnt += (c > 0u) ? 1u : 0u; mine = (j == x) ? c : mine; }
        if (sum == G) break;
        __builtin_amdgcn_s_sleep(1);
        if ((++sp & 255u) == 0u) { if (xb_ld(&bar[XB_TMO])) break; if (sp > XB_SPIN_CAP) { atomicAdd(&bar[XB_TMO], 1u); break; } }
    }
    nloc = mine > 0u ? mine : 1u; nx = cnt > 0u ? cnt : 1u;
}

__device__ __forceinline__ void xcd_barrier(const XcdBarrier& b) {
    asm volatile("s_waitcnt vmcnt(0)" ::: "memory");
    __syncthreads();
    if (threadIdx.x == 0) {
        unsigned* bar = b.bar;
        __builtin_amdgcn_s_waitcnt(0);
        unsigned nloc = b.st[0], nx = b.st[1];
        if (nloc == 0u) { xcd_barrier_complete(bar, b.x, nloc, nx); b.st[0] = nloc; b.st[1] = nx; }
        const unsigned old = xb_add(&bar[XB_XSUB(b.x)], 1u);
        const unsigned gen = old / nloc;
        if (old + 1u == (gen + 1u) * nloc) {
            __builtin_amdgcn_fence(__ATOMIC_RELEASE, "agent");
            asm volatile("s_waitcnt vmcnt(0)" ::: "memory");
            const unsigned og = xb_add(&bar[XB_TOP], 1u);
            const unsigned tg = og / nx;
            if (og + 1u == (tg + 1u) * nx) xb_add(&bar[XB_TOPGEN], 1u);
            else XB_SPIN(xb_ld(&bar[XB_TOPGEN]) == tg, bar);
            __builtin_amdgcn_fence(__ATOMIC_ACQUIRE, "agent");
            xb_add(&bar[XB_XGEN(b.x)], 1u);
            asm volatile("s_waitcnt vmcnt(0)" ::: "memory");
        } else {
            XB_SPIN(xb_ld(&bar[XB_XGEN(b.x)]) == gen, bar);
            __builtin_amdgcn_fence(__ATOMIC_ACQUIRE, "agent");
            asm volatile("s_waitcnt vmcnt(0)" ::: "memory");
        }
    }
    __syncthreads();
}

constexpr int LDS_BYTES = 155648;
constexpr int N_PHASES = 26;
__global__ void __launch_bounds__(NTHREADS, 2) fwd_megakernel(Args a) {
    extern __shared__ __attribute__((aligned(16))) unsigned char lds_raw[];
    LAS unsigned char* lds = (LAS unsigned char*)lds_raw;
    volatile LAS unsigned* bar_st = (volatile LAS unsigned*)(lds + LDS_BYTES - 64);
    if (threadIdx.x < 16) bar_st[threadIdx.x] = 0u;
    __syncthreads();
    XcdBarrier xbar = xcd_barrier_post((unsigned*)(a.ws + WS_CTL_BAR), bar_st);
    const int wave_s_ = __builtin_amdgcn_readfirstlane((int)threadIdx.x >> 6);
#define TIDS() unsigned char* ws = a.ws; asm volatile("" : "+s"(ws)); ws = (unsigned char*)(__attribute__((address_space(1))) unsigned char*)ws;     int tid; asm volatile("v_mbcnt_lo_u32_b32 %0, -1, 0\n\tv_mbcnt_hi_u32_b32 %0, -1, %0" : "=&v"(tid)); tid += wave_s_ * 64; asm volatile("" : "+v"(tid)); const int lane = tid & 63, wave = __builtin_amdgcn_readfirstlane(tid >> 6); (void)lane; (void)wave
    const int lo = a.ph_lo, hi = a.ph_hi;
#define xb ((bf16_t*)(ws + WS_XB))
#define cat ((bf16_t*)(ws + WS_CAT))
#define ssq ((float*)(ws + WS_SSQ))
#define vssq ((float*)(ws + WS_VSSQ))
#define G ((float*)(ws + WS_G))
#define MQ ((bf16_t*)(ws + WS_MQ))
#define memKV ((bf16_t*)(ws + WS_MEMKV))
#define PU ((bf16_t*)(ws + WS_PROJ))
#define PV ((bf16_t*)(ws + WS_PROJ + 96 * MiB))
#define KVG ((bf16_t*)(ws + WS_PROJ + 96 * MiB))
#define hid ((bf16_t*)(ws + WS_PROJ))
#define kcc ((bf16_t*)(ws + WS_KCC))
#define vcc ((bf16_t*)(ws + WS_VCC))
#define Hc ((bf16_t*)(ws + WS_HC))
#define wb (ws + WS_W + (size_t)i * W_STRIDE)
#define xres (a.out)
    const size_t kvg_stride = KVG_STRIDE_B / 2;
    int k = 0;
#define RUN(kk) (lo <= (kk) && (kk) < hi)
#if MK_MULTI
#define SEAM() do { ++k; } while (0)
#else
#define SEAM() do { if (RUN(k) && RUN(k + 1)) { if (lo < 0) cg::this_grid().sync(); else xcd_barrier(xbar); } ++k; } while (0)
#endif
    const int G_ = (int)gridDim.x, bx = (int)blockIdx.x;

    if (RUN(k)) { TIDS(); p0_prologue(a, lds, tid, lane, wave); }
    SEAM();

    for (int i = 0; i < 4; ++i) {
        const int j = i >> 1; const bool odd = (i & 1) != 0;
        if (RUN(k)) {
            TIDS();
            if (i == 0) {
                float* b1 = (float*)(ws + WS_MISC + OFF_BIAS1); const float* bp = (const float*)(ws + WS_MISC + OFF_BIAS1P);
                for (int e = bx * NTHREADS + tid; e < 1024; e += G_ * NTHREADS) { float s = 0.f; for (int ks = 0; ks < 16; ++ks) s += bp[((e >> 8) * 16 + ks) * 256 + (e & 255)]; b1[e] = s; }
            }
            if (!odd) {
                pg8::Gemm g{xb, (const bf16_t*)(wb + OFF_IN), MTOK, 1792, 1024, 1024}; pg8::StaticOrder S; S.init(MTOK, 1792, G_, bx, 1);
                pg8::EpiGmlpIn E{ssq, PU, PV, MQ, vssq};
                pg8::gemm_phase<pg8::EpiGmlpIn, pg8::StaticOrder, true, true>(lds, g, S, E, tid);
            } else {
                pg8::Gemm g{xb, (const bf16_t*)(wb + OFF_IN), MTOK, 2816, 1024, 1024}; pg8::StaticOrder S; S.init(MTOK, 2816, G_, bx, 1);
                pg8::EpiNsaIn E{ssq, (const float*)(ws + WS_ROPE), PU, KVG, MQ, G, kvg_stride};
                pg8::gemm_phase<pg8::EpiNsaIn, pg8::StaticOrder, true, true>(lds, g, S, E, tid);
            }
            if (i == 0) {
                pg8::Gemm g{(const bf16_t*)(ws + WS_MEMB), (const bf16_t*)(ws + WS_WMKV), 2048, 2048, 1024, 1024}; pg8::StaticOrder S; S.init(2048, 2048, G_, bx);
                pg8::EpiMemKV E{(const float*)(ws + WS_MISC + OFF_MEMRINV), memKV};
                pg8::gemm_phase<pg8::EpiMemKV, pg8::StaticOrder, true, true>(lds, g, S, E, tid);
            }
        }
        SEAM();
        if (!odd) {
            if (RUN(k)) {
                TIDS();
                spatial_phase(lds, PU, PV, vssq, a.in[11] + j * 768, a.in[13] + j * 12 * 128, (const bf16_t*)(wb + OFF_WSB), cat, tid, lane, wave);
                memattn_phase(lds, MQ, memKV, i, cat, tid, lane, wave, bx, G_);
            }
            SEAM();
        } else {
            if (RUN(k)) {
                TIDS();
                int bxs = bx; asm volatile("" : "+s"(bxs));
                const int which = bxs >= 64 ? 1 : 0; const int c = bxs < 128 ? (bxs & 63) : (1 << 20);
                pg8::Gemm g{KVG + (size_t)which * kvg_stride, (const bf16_t*)(wb + (which ? OFF_CV1 : OFF_CK1)), 16384, 256, 2048, 1024}; pg8::StaticOrder S; S.init(16384, 256, G_, c);
                pg8::EpiCmp1 E{(const float*)(ws + WS_MISC + OFF_BIAS1) + (j * 2 + which) * 256, Hc + (size_t)which * 16384 * 256};
                pg8::gemm_phase<pg8::EpiCmp1, pg8::StaticOrder, true, true>(lds, g, S, E, tid);
                if (bxs >= 128) memattn_phase(lds, MQ, memKV, i, cat, tid, lane, wave, bxs - 128, G_ - 128);
            }
            SEAM();
            if (RUN(k)) {
                TIDS();
                cmp2_phase(Hc, (const bf16_t*)(wb + OFF_CK2), (const bf16_t*)(wb + OFF_CV2), kcc, vcc, lane, wave);
                if (G_ <= 128) memattn_phase(lds, MQ, memKV, i, cat, tid, lane, wave, bx, G_);
            }
            SEAM();
            if (RUN(k)) { TIDS(); nsa_phase(lds, PU, KVG, kvg_stride, kcc, vcc, G, cat, tid, lane, wave); }
            SEAM();
        }
        if (RUN(k)) {
            TIDS();
            pg8::Gemm g{cat, (const bf16_t*)(wb + OFF_OUT), MTOK, 1024, 1024, 1024}; pg8::StaticOrder S; S.init(MTOK, 1024, G_, bx);
            pg8::EpiResid E{(i == 0) ? a.in[0] : (const float*)xres, xres, xb, ssq};
            pg8::gemm_phase<pg8::EpiResid, pg8::StaticOrder, true, true>(lds, g, S, E, tid);
        }
        SEAM();
        if (RUN(k)) {
            TIDS();
            pg8::Gemm g{xb, (const bf16_t*)(wb + OFF_GU), MTOK, 5632, 1024, 1024}; pg8::StaticOrder S; S.init(MTOK, 5632, G_, bx, 1);
            pg8::EpiGateUp E{ssq, hid};
            pg8::gemm_phase<pg8::EpiGateUp, pg8::StaticOrder, true, true>(lds, g, S, E, tid);
        }
        SEAM();
        if (RUN(k)) {
            TIDS();
            pg8::Gemm g{hid, (const bf16_t*)(wb + OFF_D), MTOK, 1024, 2816, 2816}; pg8::StaticOrder S; S.init(MTOK, 1024, G_, bx);
            pg8::EpiResid E{(const float*)xres, xres, xb, ssq};
            pg8::gemm_phase<pg8::EpiResid, pg8::StaticOrder, true, true>(lds, g, S, E, tid);
        }
        SEAM();
    }
    if (RUN(k)) { TIDS(); final_norm_phase(xres, ssq, a.in[5], lane, wave); }
#undef RUN
#undef SEAM
#undef xb
#undef cat
#undef ssq
#undef vssq
#undef G
#undef MQ
#undef memKV
#undef PU
#undef PV
#undef KVG
#undef hid
#undef kcc
#undef vcc
#undef Hc
#undef wb
#undef xres
}

extern "C" void kernel_launch(void* const* d_in, const int* in_sizes, int n_in, void* d_out, int out_size, void* d_ws, size_t ws_size, hipStream_t stream) {
    static int grid = 0;
    if (grid == 0) {
        if (n_in != 23 || out_size != MTOK * DM || ws_size < WS_END) { fprintf(stderr, "kernel_launch: unexpected shapes (n_in %d out %d ws %zu need %zu)\n", n_in, out_size, ws_size, (size_t)WS_END); grid = -1; return; }
        int dev = 0, cus = 0, per_cu = 0;
        hipGetDevice(&dev); hipDeviceGetAttribute(&cus, hipDeviceAttributeMultiprocessorCount, dev);
        if (hipFuncSetAttribute((const void*)fwd_megakernel, hipFuncAttributeMaxDynamicSharedMemorySize, LDS_BYTES) != hipSuccess) { fprintf(stderr, "kernel_launch: hipFuncSetAttribute failed\n"); grid = -1; return; }
        if (hipOccupancyMaxActiveBlocksPerMultiprocessor(&per_cu, (const void*)fwd_megakernel, NTHREADS, LDS_BYTES) != hipSuccess || per_cu < 1) { fprintf(stderr, "kernel_launch: occupancy query says %d\n", per_cu); per_cu = 1; }
        (void)hipGetLastError();
        grid = cus;
        if (grid > 256) grid = 256;
    }
    if (grid < 0) return;
    if (hipMemsetAsync((char*)d_ws + WS_CTL_BAR, 0, 16384, stream) != hipSuccess) { fprintf(stderr, "kernel_launch: memset of the barrier words failed\n"); return; }
    Args a{};
    for (int i = 0; i < 23; ++i) a.in[i] = (const float*)d_in[i];
    a.out = (float*)d_out; a.ws = (unsigned char*)d_ws;
#if MK_MULTI
    for (int p = 0; p < N_PHASES; ++p) { a.ph_lo = p; a.ph_hi = p + 1; hipLaunchKernelGGL(fwd_megakernel, dim3(grid), dim3(NTHREADS), LDS_BYTES, stream, a); }
#else
    a.ph_lo = 0; a.ph_hi = N_PHASES;
    void* args[] = {&a};
    hipError_t e = hipLaunchCooperativeKernel((const void*)fwd_megakernel, dim3(grid), dim3(NTHREADS), args, LDS_BYTES, stream);
    if (e != hipSuccess) fprintf(stderr, "kernel_launch: cooperative launch failed: %s (grid %d)\n", hipGetErrorString(e), grid);
#endif
}
```

```cpp
#include <hip/hip_runtime.h>
#include <hip/hip_cooperative_groups.h>
#include <cstdio>
#include <cstdint>
namespace cg = cooperative_groups;
#define GAS __attribute__((address_space(1)))

#ifndef MK_MULTI
#define MK_MULTI 0
#endif

namespace pg8 {
#define PG8_LAS __attribute__((address_space(3)))
typedef unsigned short bf16_t;
typedef short bf16x8 __attribute__((ext_vector_type(8)));
typedef float f32x4 __attribute__((ext_vector_type(4)));
typedef unsigned u32x4 __attribute__((ext_vector_type(4)));
constexpr int BM = 256, BK = 64, HALF = 128, HTB = HALF * BK * 2  , STAGE_BYTES = 8 * HTB, NXCD = 8, WGM = 8;

__host__ __device__ __forceinline__ int lds_byte(int r, int c) { const int st = (r >> 4) * 2 + (c >> 5), rr = r & 15, cc = c & 31, ob = rr * 64 + cc * 2; return st * 1024 + (ob ^ (((ob >> 9) & 1) << 5)); }
__host__ __device__ __forceinline__ void stage_rc(int b, int& R, int& C) { const int st = b / 1024, sb = b % 1024, swz = sb ^ (((sb >> 9) & 1) << 5); R = (st >> 1) * 16 + swz / 64; C = (st & 1) * 32 + (swz % 64) / 2; }
__host__ __device__ __forceinline__ int perm32(int rho) { const int n = rho >> 4, i = rho & 15; return 8 * (i >> 2) + 4 * n + (i & 3); }

struct Unit { int pm, pn; };
struct Gemm { const bf16_t* A; const bf16_t* Bt; int M, N, K, lda; };

struct StaticOrder {
    int nM, nN, nwg, G, c, rev;
    __host__ __device__ void init(int M, int N, int G_, int c_, int rev_ = 0) { nM = M / BM; nN = N / BM; nwg = nM * nN; G = G_; c = c_; rev = rev_; }
    __host__ __device__ bool next(int i, Unit& u) const {
        const long L = (long)i * G + c; if (L >= nwg) return false;
        int wgid = (int)L; { const int q = nwg / NXCD, r = nwg % NXCD, xcd = wgid % NXCD, off = wgid / NXCD; wgid = (xcd < r ? xcd * (q + 1) : r * (q + 1) + (xcd - r) * q) + off; }
        const int nig = WGM * nN, gid = wgid / nig, fm = gid * WGM, gsz = (nM - fm) < WGM ? (nM - fm) : WGM;
        u.pm = fm + ((wgid % nig) % gsz); u.pn = (wgid % nig) / gsz; if (rev) u.pm = nM - 1 - u.pm; return true;
    }
    __device__ __forceinline__ void a_ready(const Unit&) const {}
    __device__ __forceinline__ void done(const Unit&) const {}
};


__device__ __forceinline__ unsigned cvt_pk_bf16(float lo, float hi) { unsigned r; asm volatile("v_cvt_pk_bf16_f32 %0, %1, %2" : "=v"(r) : "v"(lo), "v"(hi)); return r; }

typedef unsigned u32x2 __attribute__((ext_vector_type(2)));
__device__ __forceinline__ float xsum16(float v) { const auto r = __builtin_amdgcn_permlane16_swap(__float_as_uint(v), __float_as_uint(v), false, false); return __uint_as_float(r[0]) + __uint_as_float(r[1]); }
__device__ __forceinline__ float xsum32(float v) { const auto r = __builtin_amdgcn_permlane32_swap(__float_as_uint(v), __float_as_uint(v), false, false); return __uint_as_float(r[0]) + __uint_as_float(r[1]); }
__device__ __forceinline__ float xmax16(float v) { const auto r = __builtin_amdgcn_permlane16_swap(__float_as_uint(v), __float_as_uint(v), false, false); return fmaxf(__uint_as_float(r[0]), __uint_as_float(r[1])); }
__device__ __forceinline__ float xmax32(float v) { const auto r = __builtin_amdgcn_permlane32_swap(__float_as_uint(v), __float_as_uint(v), false, false); return fmaxf(__uint_as_float(r[0]), __uint_as_float(r[1])); }

__device__ __forceinline__ float bf2f(unsigned short h) { return __uint_as_float((unsigned)h << 16); }
__device__ __forceinline__ float fast_sigmoid(float x) { return __builtin_amdgcn_rcpf(1.f + __builtin_amdgcn_exp2f(-1.4426950408889634f * x)); }
__device__ __forceinline__ float gelu_tanh(float x) { const float u = 0.7978845608028654f * (x + 0.044715f * x * x * x); return x * fast_sigmoid(2.f * u); }
__device__ __forceinline__ float silu_f(float x) { return x * fast_sigmoid(x); }
__device__ __forceinline__ u32x4 pack8(const f32x4 a, const f32x4 b) { u32x4 w; w.x = cvt_pk_bf16(a[0], a[1]); w.y = cvt_pk_bf16(a[2], a[3]); w.z = cvt_pk_bf16(b[0], b[1]); w.w = cvt_pk_bf16(b[2], b[3]); return w; }
__device__ __forceinline__ float sumsq4(const f32x4 a) { return (a[0] * a[0] + a[1] * a[1]) + (a[2] * a[2] + a[3] * a[3]); }
constexpr float NORM_EPS = 1e-6f;
__device__ __forceinline__ float row_rinv16(const float* ssq, int row) {
    const GAS f32x4* p = (const GAS f32x4*)(ssq + (size_t)row * 16); const f32x4 a = p[0], b = p[1], c = p[2], d = p[3];
    const float s = (((a[0] + a[1]) + (a[2] + a[3])) + ((b[0] + b[1]) + (b[2] + b[3]))) + (((c[0] + c[1]) + (c[2] + c[3])) + ((d[0] + d[1]) + (d[2] + d[3])));
    return __builtin_amdgcn_rsqf(s * (1.0f / 1024.0f) + NORM_EPS);
}
constexpr float QSCALE = 0.125f * 1.4426950408889634f;


struct EpiGmlpIn { static constexpr bool PERM = true, AFTER_DRAIN = false;
    const float* ssq; bf16_t* U; bf16_t* V; bf16_t* MQ; float* vssq;
    __device__ __forceinline__ void operator()(const f32x4 (&acc)[2][2][4][2], const Unit& u, int wr, int wc, int fr, int fq) const {
        const int pn = u.pn;
#pragma unroll
        for (int ai = 0; ai < 2; ++ai)
#pragma unroll
            for (int m = 0; m < 4; ++m) {
                const int row = u.pm * BM + ai * HALF + wr * 64 + m * 16 + fr;
                const float rinv = row_rinv16(ssq, row);
#pragma unroll
                for (int bj = 0; bj < 2; ++bj) {
                    const int col = pn * BM + bj * HALF + wc * 32 + 8 * fq;
                    f32x4 v0 = acc[ai][bj][m][0] * rinv, v1 = acc[ai][bj][m][1] * rinv;
                    if (pn < 6) {
#pragma unroll
                        for (int i = 0; i < 4; ++i) { v0[i] = gelu_tanh(v0[i]); v1[i] = gelu_tanh(v1[i]); }
                        if (pn < 3) { *(GAS u32x4*)(U + (size_t)row * 768 + col) = pack8(v0, v1); }
                        else {
                            *(GAS u32x4*)(V + (size_t)row * 768 + (col - 768)) = pack8(v0, v1);
                            float s = sumsq4(v0) + sumsq4(v1); s = pg8::xsum16(s); s = pg8::xsum32(s);
                            if (fq == 0) ((GAS float*)vssq)[(size_t)row * 24 + (pn - 3) * 8 + bj * 4 + wc] = s;
                        }
                    } else { v0 = v0 * QSCALE; v1 = v1 * QSCALE; *(GAS u32x4*)(MQ + (size_t)row * 256 + (col - 1536)) = pack8(v0, v1); }
                }
            }
    }
};

struct EpiNsaIn { static constexpr bool PERM = true, AFTER_DRAIN = false;
    const float* ssq; const float* rope; bf16_t* Q; bf16_t* KVG; bf16_t* MQ; float* G;
    size_t kvg_stride;
    __device__ __forceinline__ void operator()(const f32x4 (&acc)[2][2][4][2], const Unit& u, int wr, int wc, int fr, int fq) const {
        const int pn = u.pn;
        const bool rope_t = (pn <= 3) || pn == 5 || pn == 7;
        const float sc = (pn < 3 || pn == 9) ? QSCALE : 1.0f;
#pragma unroll
        for (int ai = 0; ai < 2; ++ai)
#pragma unroll
            for (int m = 0; m < 4; ++m) {
                const int row = u.pm * BM + ai * HALF + wr * 64 + m * 16 + fr;
                const float rinv = row_rinv16(ssq, row);
                f32x4 lo0 = acc[ai][0][m][0] * rinv, lo1 = acc[ai][0][m][1] * rinv, hi0 = acc[ai][1][m][0] * rinv, hi1 = acc[ai][1][m][1] * rinv;
                if (pn == 10) {
#pragma unroll
                    for (int i = 0; i < 4; ++i) {
                        int col = wc * 32 + 8 * fq + i;
                        if (col < 36) ((GAS float*)G)[(size_t)row * 36 + col] = fast_sigmoid(lo0[i]);
                        col += 4;
                        if (col < 36) ((GAS float*)G)[(size_t)row * 36 + col] = fast_sigmoid(lo1[i]);
                    }
                    continue;
                }
                const int pos = row & 8191;
                if (rope_t) {
                    const GAS f32x4* cs = (const GAS f32x4*)(rope + ((size_t)pos * 32 + 8 * fq) * 2);
                    const f32x4 c01 = cs[0], c23 = cs[1], c45 = cs[2], c67 = cs[3];
#define ROT(a, b, c, s) do { const float na_ = (a) * (c) - (b) * (s), nb_ = (b) * (c) + (a) * (s); (a) = na_; (b) = nb_; } while (0)
                    ROT(lo0[0], hi0[0], c01[0], c01[1]); ROT(lo0[1], hi0[1], c01[2], c01[3]); ROT(lo0[2], hi0[2], c23[0], c23[1]); ROT(lo0[3], hi0[3], c23[2], c23[3]);
                    ROT(lo1[0], hi1[0], c45[0], c45[1]); ROT(lo1[1], hi1[1], c45[2], c45[3]); ROT(lo1[2], hi1[2], c67[0], c67[1]); ROT(lo1[3], hi1[3], c67[2], c67[3]);
#undef ROT
                }
                lo0 = lo0 * sc; lo1 = lo1 * sc; hi0 = hi0 * sc; hi1 = hi1 * sc;
                bf16_t* p;
                if (pn < 3) p = Q + (size_t)row * 768 + (pn * 4 + wc) * 64 + 8 * fq;
                else if (pn == 9) p = MQ + (size_t)row * 256 + wc * 64 + 8 * fq;
                else p = KVG + (size_t)(pn - 3) * kvg_stride + ((size_t)((row >> 13) * 4 + wc) * 8192 + pos) * 64 + 8 * fq;
                *(u32x4*)p = pack8(lo0, lo1); *(GAS u32x4*)(p + 32) = pack8(hi0, hi1);
            }
    }
};

struct EpiResid { static constexpr bool PERM = true, AFTER_DRAIN = false;
    const float* xsrc; float* xdst; bf16_t* xb; float* ssq;
    __device__ __forceinline__ void operator()(const f32x4 (&acc)[2][2][4][2], const Unit& u, int wr, int wc, int fr, int fq) const {
#pragma unroll
        for (int ai = 0; ai < 2; ++ai) {
            f32x4 xv[4][2][2];
#pragma unroll
            for (int m = 0; m < 4; ++m)
#pragma unroll
                for (int bj = 0; bj < 2; ++bj) {
                    const size_t off = (size_t)(u.pm * BM + ai * HALF + wr * 64 + m * 16 + fr) * 1024 + u.pn * BM + bj * HALF + wc * 32 + 8 * fq;
                    xv[m][bj][0] = __builtin_nontemporal_load((const GAS f32x4*)(xsrc + off)); xv[m][bj][1] = __builtin_nontemporal_load((const GAS f32x4*)(xsrc + off + 4));
                }
            asm volatile("" ::: "memory");
#pragma unroll
            for (int m = 0; m < 4; ++m) {
                const int row = u.pm * BM + ai * HALF + wr * 64 + m * 16 + fr; float s = 0.f;
#pragma unroll
                for (int bj = 0; bj < 2; ++bj) {
                    const size_t off = (size_t)row * 1024 + u.pn * BM + bj * HALF + wc * 32 + 8 * fq;
                    const f32x4 x0 = xv[m][bj][0] + acc[ai][bj][m][0], x1 = xv[m][bj][1] + acc[ai][bj][m][1];
                    __builtin_nontemporal_store(x0, (GAS f32x4*)(xdst + off)); __builtin_nontemporal_store(x1, (GAS f32x4*)(xdst + off + 4)); *(GAS u32x4*)(xb + off) = pack8(x0, x1);
                    s += sumsq4(x0) + sumsq4(x1);
                }
                s = pg8::xsum16(s); s = pg8::xsum32(s);
                if (fq == 0) ((GAS float*)ssq)[(size_t)row * 16 + u.pn * 4 + wc] = s;
            }
            asm volatile("" ::: "memory");
        }
    }
};

typedef float f32x2e __attribute__((ext_vector_type(2)));
struct EpiGateUp { static constexpr bool PERM = true, AFTER_DRAIN = false;
    const float* ssq; bf16_t* hid;
    static __device__ __forceinline__ unsigned swiglu2(float g0, float g1, float u0, float u1, float a, float r2) {
        const f32x2e g = (f32x2e){g0, g1}, u = (f32x2e){u0, u1};
        const f32x2e t = g * a;
        f32x2e e; e.x = __builtin_amdgcn_exp2f(t.x); e.y = __builtin_amdgcn_exp2f(t.y);
        const f32x2e d = e + 1.0f;
        f32x2e r; r.x = __builtin_amdgcn_rcpf(d.x); r.y = __builtin_amdgcn_rcpf(d.y);
        const f32x2e h = (g * u) * (r * r2);
        return cvt_pk_bf16(h.x, h.y);
    }
    __device__ __forceinline__ void operator()(const f32x4 (&acc)[2][2][4][2], const Unit& u, int wr, int wc, int fr, int fq) const {
#pragma unroll
        for (int ai = 0; ai < 2; ++ai)
#pragma unroll
            for (int m = 0; m < 4; ++m) {
                const int row = u.pm * BM + ai * HALF + wr * 64 + m * 16 + fr;
                const float rinv = row_rinv16(ssq, row);
                const float a = rinv * -1.4426950408889634f, r2 = rinv * rinv;
                u32x4 w;
                w.x = swiglu2(acc[ai][0][m][0][0], acc[ai][0][m][0][1], acc[ai][1][m][0][0], acc[ai][1][m][0][1], a, r2);
                w.y = swiglu2(acc[ai][0][m][0][2], acc[ai][0][m][0][3], acc[ai][1][m][0][2], acc[ai][1][m][0][3], a, r2);
                w.z = swiglu2(acc[ai][0][m][1][0], acc[ai][0][m][1][1], acc[ai][1][m][1][0], acc[ai][1][m][1][1], a, r2);
                w.w = swiglu2(acc[ai][0][m][1][2], acc[ai][0][m][1][3], acc[ai][1][m][1][2], acc[ai][1][m][1][3], a, r2);
                *(GAS u32x4*)(hid + (size_t)row * 2816 + u.pn * 128 + wc * 32 + 8 * fq) = w;
            }
    }
};

struct EpiMemKV { static constexpr bool PERM = true, AFTER_DRAIN = false;
    const float* rinv; bf16_t* O;
    __device__ __forceinline__ void operator()(const f32x4 (&acc)[2][2][4][2], const Unit& u, int wr, int wc, int fr, int fq) const {
#pragma unroll
        for (int ai = 0; ai < 2; ++ai)
#pragma unroll
            for (int m = 0; m < 4; ++m) {
                const int row = u.pm * BM + ai * HALF + wr * 64 + m * 16 + fr; const float r = ((const GAS float*)rinv)[row];
#pragma unroll
                for (int bj = 0; bj < 2; ++bj)
                    *(GAS u32x4*)(O + (size_t)row * 2048 + u.pn * BM + bj * HALF + wc * 32 + 8 * fq) = pack8(acc[ai][bj][m][0] * r, acc[ai][bj][m][1] * r);
            }
    }
};

struct EpiCmp1 { static constexpr bool PERM = true, AFTER_DRAIN = false;
    const float* bias; bf16_t* H;
    __device__ __forceinline__ void operator()(const f32x4 (&acc)[2][2][4][2], const Unit& u, int wr, int wc, int fr, int fq) const {
#pragma unroll
        for (int bj = 0; bj < 2; ++bj) {
            const int col = bj * HALF + wc * 32 + 8 * fq;
            const f32x4 b0 = *(const GAS f32x4*)(bias + col), b1 = *(const GAS f32x4*)(bias + col + 4);
#pragma unroll
            for (int ai = 0; ai < 2; ++ai)
#pragma unroll
                for (int m = 0; m < 4; ++m) {
                    const int row = u.pm * BM + ai * HALF + wr * 64 + m * 16 + fr;
                    f32x4 v0 = acc[ai][bj][m][0] + b0, v1 = acc[ai][bj][m][1] + b1;
#pragma unroll
                    for (int i = 0; i < 4; ++i) { v0[i] = silu_f(v0[i]); v1[i] = silu_f(v1[i]); }
                    *(GAS u32x4*)(H + (size_t)row * 256 + col) = pack8(v0, v1);
                }
        }
    }
};

template <class Epi, class Sched, bool ALIGN_EPI = false, bool SP2 = false>
__device__ __forceinline__ void gemm_phase(PG8_LAS unsigned char* lds, const Gemm g, const Sched& S, const Epi& E, int tid_in) {
    int tid0_ = tid_in; asm volatile("" : "+v"(tid0_));
    const int tid = tid0_, wid = __builtin_amdgcn_readfirstlane(tid >> 6), lane = tid & 63, wr = wid >> 2, wc = wid & 3, fr = lane & 15, fq = lane >> 4;
    const int K = g.K, nt = K / BK;
    unsigned voffA[2], voffB[2];
#pragma unroll
    for (int i = 0; i < 2; ++i) { int R, C; stage_rc(tid * 16 + i * 8192, R, C); const int Rb = Epi::PERM ? ((R & ~31) + perm32(R & 31)) : R;
        voffA[i] = (unsigned)(R * g.lda + C) * 2u; voffB[i] = (unsigned)(Rb * K + C) * 2u; }
    const size_t kstep = (size_t)(BK * 2);
    const size_t hstep = (size_t)HALF * K * 2;
    const size_t tstep = 2 * hstep;
    const size_t hstepA = (size_t)HALF * g.lda * 2, tstepA = 2 * hstepA;
    const unsigned ldsw = (unsigned)wid * 1024u;
    const int aoff = lds_byte(wr * 64 + fr, fq * 8), boff = lds_byte(wc * 32 + fr, fq * 8);
#define PG8_SA(b, h) (((b) * 2 + (h)) * HTB)
#define PG8_SB(b, h) ((4 + (b) * 2 + (h)) * HTB)
#define PG8_STAGE(bufoff, gbase, voff) do { _Pragma("unroll") for (int _i = 0; _i < 2; ++_i) \
        __builtin_amdgcn_global_load_lds((const unsigned*)((const char*)(gbase) + (voff)[_i]), (PG8_LAS unsigned*)(lds + (bufoff) + ldsw + _i * 8192), 16, 0, 0); } while (0)
#define PG8_LDA(dst, b, h) do { _Pragma("unroll") for (int m = 0; m < 4; ++m) _Pragma("unroll") for (int k = 0; k < 2; ++k) dst[m][k] = *(const PG8_LAS bf16x8*)(lds + PG8_SA(b, h) + aoff + m * 2048 + k * 1024); } while (0)
#define PG8_LDB(dst, b, h) do { _Pragma("unroll") for (int n = 0; n < 2; ++n) _Pragma("unroll") for (int k = 0; k < 2; ++k) dst[n][k] = *(const PG8_LAS bf16x8*)(lds + PG8_SB(b, h) + boff + n * 2048 + k * 1024); } while (0)
#define PG8_MMA(ai, bj, At, Bt) do { __builtin_amdgcn_s_setprio(1); _Pragma("unroll") for (int m = 0; m < 4; ++m) _Pragma("unroll") for (int n = 0; n < 2; ++n) _Pragma("unroll") for (int k = 0; k < 2; ++k) \
        acc[ai][bj][m][n] = __builtin_amdgcn_mfma_f32_16x16x32_bf16(Bt[n][k], At[m][k], acc[ai][bj][m][n], 0, 0, 0); __builtin_amdgcn_s_setprio(0); } while (0)
#define PG8_WAIT_V(n) asm volatile("s_waitcnt vmcnt(" #n ")" ::: "memory")
#define PG8_WAIT_L(n) asm volatile("s_waitcnt lgkmcnt(" #n ")" ::: "memory")
#define PG8_BAR __builtin_amdgcn_s_barrier()
#define PG8_SCHED __builtin_amdgcn_sched_barrier(0)
    Unit cur, nxt; int ui = 0;
    if (!S.next(0, cur)) return;
    f32x4 acc[2][2][4][2];
    float zf_ = 0.f; asm volatile("" : "+v"(zf_));
#pragma unroll
    for (int a = 0; a < 2; ++a)
#pragma unroll
        for (int b = 0; b < 2; ++b)
#pragma unroll
            for (int m = 0; m < 4; ++m)
#pragma unroll
                for (int n = 0; n < 2; ++n) acc[a][b][m][n] = (f32x4){zf_, zf_, zf_, zf_};
    bf16x8 At[4][2], B0[2][2], B1[2][2];
    const char* cA = (const char*)g.A + (size_t)cur.pm * tstepA; const char* cB = (const char*)g.Bt + (size_t)cur.pn * tstep;
    S.a_ready(cur);
    if constexpr (SP2) {
        PG8_STAGE(PG8_SB(0, 0), cB, voffB); PG8_STAGE(PG8_SB(0, 1), cB + hstep, voffB); PG8_STAGE(PG8_SA(0, 0), cA, voffA); PG8_STAGE(PG8_SA(0, 1), cA + hstepA, voffA);
        if (wr == 1) PG8_BAR;
        PG8_WAIT_V(2); PG8_BAR;
        PG8_STAGE(PG8_SB(1, 0), cB + kstep, voffB); PG8_STAGE(PG8_SA(1, 0), cA + kstep, voffA); PG8_STAGE(PG8_SB(1, 1), cB + hstep + kstep, voffB);
        PG8_WAIT_V(6); PG8_BAR;
    } else {
        PG8_STAGE(PG8_SB(0, 0), cB, voffB); PG8_STAGE(PG8_SA(0, 0), cA, voffA); PG8_STAGE(PG8_SB(0, 1), cB + hstep, voffB); PG8_STAGE(PG8_SA(0, 1), cA + hstepA, voffA);
        if (wr == 1) PG8_BAR;
        PG8_WAIT_V(4); PG8_BAR;
        PG8_STAGE(PG8_SB(1, 0), cB + kstep, voffB); PG8_STAGE(PG8_SA(1, 0), cA + kstep, voffA); PG8_STAGE(PG8_SB(1, 1), cB + hstep + kstep, voffB);
        PG8_WAIT_V(6); PG8_BAR;
    }
    for (;;) {
        const bool has_next = S.next(ui + 1, nxt);
        const char* nA = has_next ? (const char*)g.A + (size_t)nxt.pm * tstepA : cA; const char* nB = has_next ? (const char*)g.Bt + (size_t)nxt.pn * tstep : cB;
        for (int t = 0; t < nt; t += 2) {
            const bool last = (t == nt - 2);
            const char* a1 = cA + (size_t)(t + 1) * kstep;
            const char* a2 = last ? nA : cA + (size_t)(t + 2) * kstep; const char* b2 = last ? nB : cB + (size_t)(t + 2) * kstep;
            const char* a3 = a2 + kstep; const char* b3 = b2 + kstep;
            if (last && has_next) S.a_ready(nxt);
            if constexpr (SP2) {
            PG8_LDB(B0, 0, 0); PG8_LDB(B1, 0, 1); PG8_SCHED; PG8_LDA(At, 0, 0); PG8_STAGE(PG8_SA(1, 1), a1 + hstepA, voffA);
            PG8_WAIT_V(8); PG8_WAIT_L(0); PG8_BAR; PG8_MMA(0, 0, At, B0); PG8_MMA(0, 1, At, B1); PG8_BAR; PG8_SCHED;
            PG8_LDA(At, 0, 1); PG8_STAGE(PG8_SB(0, 0), b2, voffB); PG8_STAGE(PG8_SB(0, 1), b2 + hstep, voffB); PG8_STAGE(PG8_SA(0, 0), a2, voffA);
            PG8_WAIT_V(8); PG8_WAIT_L(0); PG8_BAR; PG8_MMA(1, 0, At, B0); PG8_MMA(1, 1, At, B1); PG8_BAR; PG8_SCHED;
            PG8_LDB(B0, 1, 0); PG8_LDB(B1, 1, 1); PG8_SCHED; PG8_LDA(At, 1, 0); PG8_STAGE(PG8_SA(0, 1), a2 + hstepA, voffA);
            PG8_WAIT_V(8); PG8_WAIT_L(0); PG8_BAR; PG8_MMA(0, 0, At, B0); PG8_MMA(0, 1, At, B1); PG8_BAR; PG8_SCHED;
            PG8_LDA(At, 1, 1); PG8_STAGE(PG8_SB(1, 0), b3, voffB); PG8_STAGE(PG8_SB(1, 1), b3 + hstep, voffB); PG8_STAGE(PG8_SA(1, 0), a3, voffA);
            PG8_WAIT_V(8); PG8_WAIT_L(0); PG8_BAR; PG8_MMA(1, 0, At, B0); PG8_MMA(1, 1, At, B1); PG8_BAR; PG8_SCHED;
            } else {
            PG8_LDB(B0, 0, 0); PG8_SCHED; PG8_LDA(At, 0, 0); PG8_STAGE(PG8_SA(1, 1), a1 + hstepA, voffA);
            PG8_WAIT_L(8); PG8_BAR; PG8_WAIT_L(0); PG8_MMA(0, 0, At, B0); PG8_BAR; PG8_SCHED;
            PG8_LDB(B1, 0, 1); PG8_STAGE(PG8_SB(0, 0), b2, voffB);
            PG8_BAR; PG8_WAIT_L(0); PG8_MMA(0, 1, At, B1); PG8_BAR;
            PG8_LDA(At, 0, 1); PG8_STAGE(PG8_SA(0, 0), a2, voffA);
            PG8_BAR; PG8_WAIT_L(0); PG8_MMA(1, 0, At, B0); PG8_BAR; PG8_SCHED;
            PG8_STAGE(PG8_SB(0, 1), b2 + hstep, voffB);
            PG8_WAIT_V(6); PG8_BAR; PG8_MMA(1, 1, At, B1); PG8_BAR;
            PG8_LDB(B0, 1, 0); PG8_SCHED; PG8_LDA(At, 1, 0); PG8_STAGE(PG8_SA(0, 1), a2 + hstepA, voffA);
            PG8_WAIT_L(8); PG8_BAR; PG8_WAIT_L(0); PG8_MMA(0, 0, At, B0); PG8_BAR; PG8_SCHED;
            PG8_LDB(B1, 1, 1); PG8_STAGE(PG8_SB(1, 0), b3, voffB);
            PG8_BAR; PG8_WAIT_L(0); PG8_MMA(0, 1, At, B1); PG8_BAR;
            PG8_LDA(At, 1, 1); PG8_STAGE(PG8_SA(1, 0), a3, voffA);
            PG8_BAR; PG8_WAIT_L(0); PG8_MMA(1, 0, At, B0); PG8_BAR; PG8_SCHED;
            PG8_STAGE(PG8_SB(1, 1), b3 + hstep, voffB);
            PG8_WAIT_V(6); PG8_BAR; PG8_MMA(1, 1, At, B1); PG8_BAR;
            }
        }
        if constexpr (ALIGN_EPI) { if (wr == 0) PG8_BAR; }
        if constexpr (!Epi::AFTER_DRAIN) { E(acc, cur, wr, wc, fr, fq); S.done(cur); }
        if (!has_next) break;
        zf_ = 0.f; asm volatile("" : "+v"(zf_));
#pragma unroll
        for (int a = 0; a < 2; ++a)
#pragma unroll
            for (int b = 0; b < 2; ++b)
#pragma unroll
                for (int m = 0; m < 4; ++m)
#pragma unroll
                    for (int n = 0; n < 2; ++n) acc[a][b][m][n] = (f32x4){zf_, zf_, zf_, zf_};
        cur = nxt; cA = nA; cB = nB; ++ui;
        if constexpr (ALIGN_EPI) { if (wr == 1) PG8_BAR; }
    }
    PG8_WAIT_V(0);
    if constexpr (!ALIGN_EPI) { if (wr == 0) PG8_BAR; }
    PG8_BAR;
    if constexpr (Epi::AFTER_DRAIN) { E.fused(acc, cur, wr, wc, fr, fq, lds, wid, lane); S.done(cur); }
#undef PG8_SA
#undef PG8_SB
#undef PG8_STAGE
#undef PG8_LDA
#undef PG8_LDB
#undef PG8_MMA
#undef PG8_WAIT_V
#undef PG8_WAIT_L
#undef PG8_BAR
#undef PG8_SCHED
}

}

using pg8::bf16_t; using pg8::bf16x8; using pg8::f32x4; using pg8::u32x4; using pg8::u32x2; using pg8::bf2f; using pg8::cvt_pk_bf16;
#define LAS __attribute__((address_space(3)))
typedef short s16x4 __attribute__((ext_vector_type(4)));
constexpr int NWAVES = 8, NTHREADS = 512;
constexpr int DM = 1024, NB = 8, SEQ = 8192, MTOK = NB * SEQ, DFF = 2816, MEMLEN = 256;
constexpr size_t MiB = 1u << 20;
constexpr size_t WS_CTL_BAR = 0;
constexpr size_t WS_MISC = 1 * MiB;
constexpr size_t OFF_MEMRINV = 0, OFF_BIAS1P = 16384, OFF_BIAS1 = 16384 + 65536;
constexpr size_t WS_ROPE = 2 * MiB;
constexpr size_t WS_WMKV = 4 * MiB;
constexpr size_t WS_W = 8 * MiB, W_STRIDE = 27 * MiB;
constexpr size_t OFF_GU = 0, OFF_D = 11534336, OFF_IN = OFF_D + 5767168, OFF_OUT = OFF_IN + 5767168, OFF_CK1 = OFF_OUT + 2097152, OFF_CV1 = OFF_CK1 + 1048576,
                 OFF_CK2 = OFF_CV1 + 1048576, OFF_CV2 = OFF_CK2 + 32768, OFF_WSB = OFF_CV2 + 32768;
static_assert(OFF_WSB + 393216 <= W_STRIDE, "weights per layer");
constexpr size_t WS_MEMB = 116 * MiB;
constexpr size_t WS_MEMKV = 120 * MiB;
constexpr size_t WS_XB = 128 * MiB;
constexpr size_t WS_CAT = 256 * MiB;
constexpr size_t WS_SSQ = 384 * MiB;
constexpr size_t WS_VSSQ = 388 * MiB;
constexpr size_t WS_G = 394 * MiB;
constexpr size_t WS_KCC = 404 * MiB, WS_VCC = 406 * MiB;
constexpr size_t WS_HC = 408 * MiB;
constexpr size_t WS_MQ = 424 * MiB;
constexpr size_t WS_PROJ = 456 * MiB;
constexpr size_t KVG_STRIDE_B = 34 * MiB;
constexpr size_t WS_END = WS_PROJ + 352 * MiB;
static_assert(96 * MiB + 6 * KVG_STRIDE_B <= 352 * MiB, "proj region");

__device__ __forceinline__ bf16x8 mk8(s16x4 a, s16x4 b) { return __builtin_shufflevector(a, b, 0, 1, 2, 3, 4, 5, 6, 7); }
#define MFMA16(a, b, c) __builtin_amdgcn_mfma_f32_16x16x32_bf16((a), (b), (c), 0, 0, 0)
__device__ __forceinline__ float wave_sum(float v) {
    v += __uint_as_float((unsigned)__builtin_amdgcn_ds_swizzle((int)__float_as_uint(v), 0x041f));
    v += __uint_as_float((unsigned)__builtin_amdgcn_ds_swizzle((int)__float_as_uint(v), 0x081f));
    v += __uint_as_float((unsigned)__builtin_amdgcn_ds_swizzle((int)__float_as_uint(v), 0x101f));
    v += __uint_as_float((unsigned)__builtin_amdgcn_ds_swizzle((int)__float_as_uint(v), 0x201f));
    v = pg8::xsum16(v); v = pg8::xsum32(v);
    return v;
}
__device__ __forceinline__ unsigned short f2bf(float f) { return (unsigned short)(cvt_pk_bf16(f, 0.f) & 0xffffu); }

struct Args { const float* in[23]; float* out; unsigned char* ws; int ph_lo, ph_hi; };

__device__ __forceinline__ void cvt_item(const float* src, int ld, int col0, int nvalid, const float* gain, bf16_t* dst, int K, int drow0, int k0, LAS float* scr, int lane) {
    const int n = lane & 31, ncl = (n < nvalid) ? n : 0, kh = lane >> 5;
    float vals[32];
#pragma unroll
    for (int i = 0; i < 32; ++i) vals[i] = __builtin_nontemporal_load((const GAS float*)src + ((size_t)(k0 + 2 * i + kh) * ld + col0 + ncl));
    if (gain) {
#pragma unroll
        for (int i = 0; i < 32; ++i) vals[i] *= ((const GAS float*)gain)[k0 + 2 * i + kh];
    }
#pragma unroll
    for (int i = 0; i < 32; ++i) scr[(2 * i + kh) * 33 + n] = (n < nvalid) ? vals[i] : 0.f;
    asm volatile("s_waitcnt lgkmcnt(0)" ::: "memory");
    const int c = lane & 7;
#pragma unroll
    for (int j = 0; j < 4; ++j) {
        const int nn = (lane >> 3) + 8 * j; const LAS float* s = scr + (8 * c) * 33 + nn;
        u32x4 o; o.x = cvt_pk_bf16(s[0 * 33], s[1 * 33]); o.y = cvt_pk_bf16(s[2 * 33], s[3 * 33]); o.z = cvt_pk_bf16(s[4 * 33], s[5 * 33]); o.w = cvt_pk_bf16(s[6 * 33], s[7 * 33]);
        *(GAS u32x4*)(dst + (size_t)(drow0 + nn) * K + k0 + 8 * c) = o;
    }
    asm volatile("s_waitcnt lgkmcnt(0)" ::: "memory");
}

struct Job { const float* src; const float* srcB; const float* gain; bf16_t* dst; int K, Nd, ld, kind; };
__device__ __forceinline__ Job job_get(const Args& a, int jidx) {
    Job J; const int i = jidx / 9, t = jidx % 9, j = i >> 1; const bool odd = (i & 1) != 0;
    unsigned char* wb = a.ws + WS_W + (size_t)i * W_STRIDE;
    J.srcB = nullptr; J.gain = nullptr; J.kind = 0; J.K = 1024; J.Nd = 0; J.ld = 0; J.src = nullptr; J.dst = nullptr;
    if (t == 0) { J.src = a.in[7] + (size_t)i * 1024 * 2816; J.srcB = a.in[8] + (size_t)i * 1024 * 2816; J.gain = a.in[3] + i * 1024; J.dst = (bf16_t*)(wb + OFF_GU); J.Nd = 5632; J.ld = 2816; J.kind = 1; }
    else if (t == 1) { J.src = a.in[9] + (size_t)i * 2816 * 1024; J.dst = (bf16_t*)(wb + OFF_D); J.K = 2816; J.Nd = 1024; J.ld = 1024; }
    else if (t == 2) { J.src = a.in[6] + (size_t)i * 1024 * 512; J.gain = a.in[4] + i * 1024; J.dst = (bf16_t*)(a.ws + WS_WMKV) + (size_t)i * 512 * 1024; J.Nd = 512; J.ld = 512; }
    else if (t == 3) {
        J.gain = a.in[2] + i * 1024; J.dst = (bf16_t*)(wb + OFF_IN);
        if (!odd) { J.src = a.in[10] + (size_t)j * 1024 * 1792; J.Nd = 1792; J.ld = 1792; }
        else { J.src = a.in[15] + (size_t)j * 1024 * 2596; J.Nd = 2816; J.ld = 2596; J.kind = 2; }
    }
    else if (t == 4) { J.src = (odd ? a.in[22] : a.in[14]) + (size_t)j * 1024 * 1024; J.dst = (bf16_t*)(wb + OFF_OUT); J.Nd = 1024; J.ld = 1024; }
    else if (odd) {
        if (t == 5) { J.src = a.in[18] + (size_t)j * 2048 * 256; J.dst = (bf16_t*)(wb + OFF_CK1); J.K = 2048; J.Nd = 256; J.ld = 256; }
        else if (t == 6) { J.src = a.in[20] + (size_t)j * 2048 * 256; J.dst = (bf16_t*)(wb + OFF_CV1); J.K = 2048; J.Nd = 256; J.ld = 256; }
        else if (t == 7) { J.src = a.in[19] + (size_t)j * 256 * 64; J.dst = (bf16_t*)(wb + OFF_CK2); J.K = 256; J.Nd = 64; J.ld = 64; }
        else { J.src = a.in[21] + (size_t)j * 256 * 64; J.dst = (bf16_t*)(wb + OFF_CV2); J.K = 256; J.Nd = 64; J.ld = 64; }
    }
    return J;
}

__device__ __forceinline__ void p0_prologue(const Args& a, LAS unsigned char* lds, int tid, int lane, int wave) {
    const int gw = blockIdx.x * NWAVES + wave, NGW = gridDim.x * NWAVES;
    const int gtid = blockIdx.x * NTHREADS + tid, NGT = gridDim.x * NTHREADS;
    unsigned char* ws = a.ws;
    {
        LAS float* scr = (LAS float*)lds + wave * (64 * 33);
        int jidx = 0, jstart = 0; Job J = job_get(a, 0); int nitems = (J.K / 64) * (J.Nd / 32);
        for (int it = gw; ; it += NGW) {
            while (jidx < 36 && it >= jstart + nitems) { jstart += nitems; ++jidx; if (jidx < 36) { J = job_get(a, jidx); nitems = (J.K / 64) * (J.Nd / 32); } }
            if (jidx >= 36) break;
            const int r = it - jstart, ng = J.Nd / 32, kb = r / ng, g32 = r % ng;
            const float* src = J.src; int col0 = g32 * 32, nvalid = 32;
            if (J.kind == 1) { const int pn = g32 >> 3, w = g32 & 7; src = (w >> 2) ? J.srcB : J.src; col0 = pn * 128 + (w & 3) * 32; }
            else if (J.kind == 2) { const int pn = g32 >> 3, w = g32 & 7;
                if (pn <= 9) { const int base = pn < 9 ? pn * 256 : 2340; col0 = base + (w & 3) * 64 + (w >> 2) * 32; }
                else if (w == 0) { col0 = 2304; } else if (w == 1) { col0 = 2336; nvalid = 4; } else { col0 = 0; nvalid = 0; } }
            cvt_item(src, J.ld, col0, nvalid, J.gain, J.dst, J.K, g32 * 32, kb * 64, scr, lane);
        }
    }
    {
        const float* x = a.in[0]; bf16_t* xb = (bf16_t*)(ws + WS_XB); float* ssq = (float*)(ws + WS_SSQ);
        for (int row = gw; row < MTOK; row += 2 * NGW) {
            const bool has2 = row + NGW < MTOK; const int row2 = has2 ? row + NGW : row;
            const GAS f32x4* xr = (const GAS f32x4*)(x + (size_t)row * DM) + lane; const GAS f32x4* xr2 = (const GAS f32x4*)(x + (size_t)row2 * DM) + lane;
            f32x4 v[4], w[4]; float s = 0.f, s2 = 0.f;
#pragma unroll
            for (int j = 0; j < 4; ++j) { v[j] = __builtin_nontemporal_load(xr + 64 * j); w[j] = __builtin_nontemporal_load(xr2 + 64 * j); }
#pragma unroll
            for (int j = 0; j < 4; ++j) { s += pg8::sumsq4(v[j]); s2 += pg8::sumsq4(w[j]); }
            s = wave_sum(s); s2 = wave_sum(s2);
            GAS u32x2* o8 = (GAS u32x2*)(xb + (size_t)row * DM) + lane; GAS u32x2* o82 = (GAS u32x2*)(xb + (size_t)row2 * DM) + lane;
#pragma unroll
            for (int j = 0; j < 4; ++j) { u32x2 a_; a_.x = cvt_pk_bf16(v[j][0], v[j][1]); a_.y = cvt_pk_bf16(v[j][2], v[j][3]); o8[64 * j] = a_;
                                          u32x2 b_; b_.x = cvt_pk_bf16(w[j][0], w[j][1]); b_.y = cvt_pk_bf16(w[j][2], w[j][3]); if (has2) o82[64 * j] = b_; }
            if (lane < 16) { ((GAS float*)ssq)[(size_t)row * 16 + lane] = (lane == 0) ? s : 0.f; if (has2) ((GAS float*)ssq)[(size_t)row2 * 16 + lane] = (lane == 0) ? s2 : 0.f; }
        }
    }
    {
        const float* mem = a.in[1]; bf16_t* mb = (bf16_t*)(ws + WS_MEMB); float* mr = (float*)(ws + WS_MISC + OFF_MEMRINV);
        for (int row = gw; row < NB * MEMLEN; row += NGW) {
            const f32x4* xr = (const f32x4*)(mem + (size_t)row * DM) + lane; f32x4 v[4]; float s = 0.f;
#pragma unroll
            for (int j = 0; j < 4; ++j) { v[j] = xr[64 * j]; s += pg8::sumsq4(v[j]); }
            s = wave_sum(s);
            u32x2* o8 = (u32x2*)(mb + (size_t)row * DM) + lane;
#pragma unroll
            for (int j = 0; j < 4; ++j) { u32x2 w; w.x = cvt_pk_bf16(v[j][0], v[j][1]); w.y = cvt_pk_bf16(v[j][2], v[j][3]); o8[64 * j] = w; }
            if (lane == 0) mr[row] = __builtin_amdgcn_rsqf(s * (1.0f / 1024.0f) + pg8::NORM_EPS);
        }
    }
    {
        float* rp = (float*)(ws + WS_ROPE);
        for (int e = gtid; e < SEQ * 32; e += NGT) {
            const int pos = e >> 5, j = e & 31;
            double inv = 1.0; for (int q = 0; q < j; ++q) inv *= 0.7498942093324559;
            const float ang = (float)pos * (float)inv;
            const double rev = (double)ang * 0.15915494309189535; const float fr = (float)(rev - __builtin_floor(rev));
            rp[2 * e] = __builtin_amdgcn_cosf(fr); rp[2 * e + 1] = __builtin_amdgcn_sinf(fr);
        }
    }
    {
        for (int e = gtid; e < 2 * 12 * 128 * 128 / 4; e += NGT) {
            const int j = e / (12 * 128 * 128 / 4), r = e % (12 * 128 * 128 / 4); const int t = (r >> 5) & 127, s0 = (r & 31) * 4;
            const f32x4 w = *(const GAS f32x4*)(a.in[12] + (size_t)j * 12 * 128 * 128 + (size_t)r * 4);
            u32x2 o; o.x = cvt_pk_bf16(s0 <= t ? w[0] : 0.f, s0 + 1 <= t ? w[1] : 0.f); o.y = cvt_pk_bf16(s0 + 2 <= t ? w[2] : 0.f, s0 + 3 <= t ? w[3] : 0.f);
            *(GAS u32x2*)((bf16_t*)(ws + WS_W + (size_t)(2 * j) * W_STRIDE + OFF_WSB) + (size_t)r * 4) = o;
        }
    }
    {
        float* bp = (float*)(ws + WS_MISC + OFF_BIAS1P);
        for (int task = gw; task < 256; task += NGW) {
            const int ng = task & 3, ks = (task >> 2) & 15, which = (task >> 6) & 1, jl = task >> 7;
            const float* pe = a.in[which ? 17 : 16] + (size_t)jl * 2048; const float* w1 = a.in[which ? 20 : 18] + (size_t)jl * 2048 * 256;
            const int n = ng * 64 + lane; float s = 0.f;
#pragma unroll 1
            for (int kb = ks * 128; kb < ks * 128 + 128; kb += 32) {
                float wv[32], pv[32];
#pragma unroll
                for (int i = 0; i < 32; ++i) { wv[i] = ((const GAS float*)w1)[(size_t)(kb + i) * 256 + n]; pv[i] = ((const GAS float*)pe)[kb + i]; }
#pragma unroll
                for (int i = 0; i < 32; ++i) s += pv[i] * wv[i];
            }
            bp[((jl * 2 + which) * 16 + ks) * 256 + n] = s;
        }
    }
}

typedef short v4i16s_t __attribute__((ext_vector_type(4)));
__device__ __forceinline__ s16x4 vtr_s(const LAS bf16_t* p) { return __builtin_bit_cast(s16x4, __builtin_amdgcn_ds_read_tr16_b64_v4i16((LAS v4i16s_t*)p)); }
__device__ __forceinline__ void spatial_phase(LAS unsigned char* lds, const bf16_t* U, const bf16_t* V, const float* vssq, const float* vgain, const float* bsp, const bf16_t* Wsb, bf16_t* cat,
                                              int tid, int lane, int wave) {
    LAS bf16_t* vS = (LAS bf16_t*)lds;
    LAS float* rv = (LAS float*)(lds + 128 * 272 * 2);
    const int lr = lane & 15, q = lane >> 4;
    for (int unit = blockIdx.x; unit < MTOK / 128; unit += gridDim.x) {
        const int r0 = unit * 128;
        __syncthreads();
        if (tid < 128) { const GAS float* p = (const GAS float*)vssq + (size_t)(r0 + tid) * 24; float s = 0.f;
#pragma unroll
            for (int i = 0; i < 24; ++i) s += p[i];
            rv[tid] = __builtin_amdgcn_rsqf(s * (1.0f / 768.0f) + pg8::NORM_EPS); }
#pragma unroll 1
        for (int g4 = 0; g4 < 3; ++g4) {
            __syncthreads();
#pragma unroll
            for (int i = 0; i < 8; ++i) {
                const int e = tid + NTHREADS * i, s = e >> 5, dc = e & 31;
                const u32x4 raw = *(const GAS u32x4*)(V + (size_t)(r0 + s) * 768 + g4 * 256 + dc * 8);
                const float rs = rv[s];
                const f32x4 g0 = *(const GAS f32x4*)(vgain + g4 * 256 + dc * 8), g1 = *(const GAS f32x4*)(vgain + g4 * 256 + dc * 8 + 4);
                u32x4 o;
                o.x = cvt_pk_bf16(__uint_as_float(raw.x << 16) * rs * g0[0], __uint_as_float(raw.x & 0xffff0000u) * rs * g0[1]);
                o.y = cvt_pk_bf16(__uint_as_float(raw.y << 16) * rs * g0[2], __uint_as_float(raw.y & 0xffff0000u) * rs * g0[3]);
                o.z = cvt_pk_bf16(__uint_as_float(raw.z << 16) * rs * g1[0], __uint_as_float(raw.z & 0xffff0000u) * rs * g1[1]);
                o.w = cvt_pk_bf16(__uint_as_float(raw.w << 16) * rs * g1[2], __uint_as_float(raw.w & 0xffff0000u) * rs * g1[3]);
                *(LAS u32x4*)(vS + s * 272 + dc * 8) = o;
            }
            __syncthreads();
            const int t = 16 * wave + lr, ksmax = (16 * wave + 15) >> 5;
#pragma unroll 1
            for (int gl = 0; gl < 4; ++gl) {
                const int g = g4 * 4 + gl;
                f32x4 acc[4];
#pragma unroll
                for (int dt = 0; dt < 4; ++dt) acc[dt] = (f32x4){0.f, 0.f, 0.f, 0.f};
                const int row = r0 + t;
                u32x2 uu4[4];
#pragma unroll
                for (int dt = 0; dt < 4; ++dt) uu4[dt] = *(const GAS u32x2*)(U + (size_t)row * 768 + g * 64 + 16 * dt + 4 * q);
                const float bias = ((const GAS float*)bsp)[g * 128 + t];
                for (int ks = 0; ks <= ksmax; ++ks) {
                    const GAS bf16_t* wp = (const GAS bf16_t*)Wsb + ((size_t)(g * 128 + t) * 128 + 32 * ks + 4 * q);
                    const bf16x8 bfr = mk8(*(const GAS s16x4*)wp, *(const GAS s16x4*)(wp + 16));
#pragma unroll
                    for (int dt = 0; dt < 4; ++dt) {
                        const LAS bf16_t* vp = vS + (32 * ks + 4 * q + (lr >> 2)) * 272 + gl * 64 + 16 * dt + 4 * (lr & 3);
                        const bf16x8 afr = mk8(vtr_s(vp), vtr_s(vp + 16 * 272));
                        acc[dt] = MFMA16(afr, bfr, acc[dt]);
                    }
                }
#pragma unroll
                for (int dt = 0; dt < 4; ++dt) {
                    const int d0 = 16 * dt + 4 * q;
                    const u32x2 uu = uu4[dt];
                    const float o0 = bf2f((unsigned short)(uu.x & 0xffffu)) * (acc[dt][0] + bias), o1 = bf2f((unsigned short)(uu.x >> 16)) * (acc[dt][1] + bias);
                    const float o2 = bf2f((unsigned short)(uu.y & 0xffffu)) * (acc[dt][2] + bias), o3 = bf2f((unsigned short)(uu.y >> 16)) * (acc[dt][3] + bias);
                    u32x2 w; w.x = cvt_pk_bf16(o0, o1); w.y = cvt_pk_bf16(o2, o3);
                    *(GAS u32x2*)(cat + (size_t)row * 1024 + g * 64 + d0) = w;
                }
            }
        }
    }
}

__device__ __forceinline__ void memattn_phase(LAS unsigned char* lds, const bf16_t* MQ, const bf16_t* memKV, int layer, bf16_t* cat, int tid, int lane, int wave, int u0, int ustride) {
    LAS bf16_t* Kl = (LAS bf16_t*)lds;
    LAS bf16_t* vT = (LAS bf16_t*)(lds + 256 * 72 * 2);
    const int lr = lane & 15, q = lane >> 4;
    for (int unit = u0; unit < 256; unit += ustride) {
        const int bh = unit >> 3, b = bh >> 2, h = bh & 3, chunk = unit & 7;
        __syncthreads();
#pragma unroll
        for (int i = 0; i < 4; ++i) {
            const int e = tid + NTHREADS * i, m = e >> 3, dc = e & 7;
            const bf16_t* src = memKV + (size_t)(b * 256 + m) * 2048 + layer * 512 + h * 64 + dc * 8;
            *(LAS u32x4*)(Kl + m * 72 + dc * 8) = *(const u32x4*)src;
            const u32x4 rv = *(const GAS u32x4*)(src + 256);
#pragma unroll
            for (int jj = 0; jj < 4; ++jj) { vT[(dc * 8 + 2 * jj) * 264 + m] = (unsigned short)(rv[jj] & 0xffffu); vT[(dc * 8 + 2 * jj + 1) * 264 + m] = (unsigned short)(rv[jj] >> 16); }
        }
        __syncthreads();
        for (int sub = 0; sub < 8; ++sub) {
            const int row = b * SEQ + chunk * 1024 + sub * 128 + 16 * wave + lr;
            bf16x8 qf[2];
#pragma unroll
            for (int ks = 0; ks < 2; ++ks) qf[ks] = *(const GAS bf16x8*)(MQ + (size_t)row * 256 + h * 64 + 32 * ks + 8 * q);
            f32x4 s[16];
#pragma unroll
            for (int mt = 0; mt < 16; ++mt) {
                s[mt] = (f32x4){0.f, 0.f, 0.f, 0.f};
#pragma unroll
                for (int ks = 0; ks < 2; ++ks) { const bf16x8 kf = *(const LAS bf16x8*)(Kl + (16 * mt + lr) * 72 + 32 * ks + 8 * q); s[mt] = MFMA16(kf, qf[ks], s[mt]); }
            }
            float mx = -1e30f;
#pragma unroll
            for (int mt = 0; mt < 16; ++mt) mx = fmaxf(mx, fmaxf(fmaxf(s[mt][0], s[mt][1]), fmaxf(s[mt][2], s[mt][3])));
            mx = pg8::xmax16(mx); mx = pg8::xmax32(mx);
            float ls = 0.f;
#pragma unroll
            for (int mt = 0; mt < 16; ++mt)
#pragma unroll
                for (int i = 0; i < 4; ++i) { const float p = __builtin_amdgcn_exp2f(s[mt][i] - mx); s[mt][i] = p; ls += p; }
            ls = pg8::xsum16(ls); ls = pg8::xsum32(ls);
            f32x4 acc[4];
#pragma unroll
            for (int dt = 0; dt < 4; ++dt) acc[dt] = (f32x4){0.f, 0.f, 0.f, 0.f};
#pragma unroll
            for (int kk = 0; kk < 8; ++kk) {
                const u32x4 pw = pg8::pack8(s[2 * kk], s[2 * kk + 1]); const bf16x8 pb = __builtin_bit_cast(bf16x8, pw);
#pragma unroll
                for (int dt = 0; dt < 4; ++dt) {
                    const LAS bf16_t* vp = vT + (16 * dt + lr) * 264 + 32 * kk + 4 * q;
                    const bf16x8 vf = mk8(*(const LAS s16x4*)vp, *(const LAS s16x4*)(vp + 16));
                    acc[dt] = MFMA16(vf, pb, acc[dt]);
                }
            }
            const float inv = __builtin_amdgcn_rcpf(ls);
#pragma unroll
            for (int dt = 0; dt < 4; ++dt) {
                u32x2 w; w.x = cvt_pk_bf16(acc[dt][0] * inv, acc[dt][1] * inv); w.y = cvt_pk_bf16(acc[dt][2] * inv, acc[dt][3] * inv);
                *(GAS u32x2*)(cat + (size_t)row * 1024 + 768 + h * 64 + 16 * dt + 4 * q) = w;
            }
        }
    }
}

__device__ __forceinline__ void cmp2_phase(const bf16_t* Hc, const bf16_t* w2k, const bf16_t* w2v, bf16_t* kcc, bf16_t* vcc, int lane, int wave) {
    const int gw = blockIdx.x * NWAVES + wave, NGW = gridDim.x * NWAVES; const int lr = lane & 15, q = lane >> 4;
    for (int unit = gw; unit < 2048; unit += NGW) {
        const int which = unit >> 10, R0 = (unit & 1023) * 16;
        const bf16_t* H = Hc + (size_t)which * 16384 * 256; const bf16_t* w2 = which ? w2v : w2k; bf16_t* dst = which ? vcc : kcc;
        f32x4 acc[4];
#pragma unroll
        for (int nt = 0; nt < 4; ++nt) acc[nt] = (f32x4){0.f, 0.f, 0.f, 0.f};
#pragma unroll
        for (int ks = 0; ks < 8; ++ks) {
            const bf16x8 bfr = *(const GAS bf16x8*)(H + (size_t)(R0 + lr) * 256 + 32 * ks + 8 * q);
#pragma unroll
            for (int nt = 0; nt < 4; ++nt) { const bf16x8 afr = *(const GAS bf16x8*)(w2 + (size_t)(16 * nt + lr) * 256 + 32 * ks + 8 * q); acc[nt] = MFMA16(afr, bfr, acc[nt]); }
        }
#pragma unroll
        for (int nt = 0; nt < 4; ++nt) { u32x2 w; w.x = cvt_pk_bf16(acc[nt][0], acc[nt][1]); w.y = cvt_pk_bf16(acc[nt][2], acc[nt][3]); *(GAS u32x2*)(dst + (size_t)(R0 + lr) * 64 + 16 * nt + 4 * q) = w; }
    }
}

typedef short v4i16_t __attribute__((ext_vector_type(4)));
__device__ __forceinline__ s16x4 vtr(const LAS bf16_t* p) { return __builtin_bit_cast(s16x4, __builtin_amdgcn_ds_read_tr16_b64_v4i16((LAS v4i16_t*)p)); }
constexpr float RESC_THR = 8.0f;
template <bool MASKED>
__device__ __forceinline__ void qk_softmax(const LAS bf16_t* Kt, const bf16x8 (&qf)[3][2], float (&m)[3], f32x4 (&lacc)[3], f32x4 (&acc)[3][4], unsigned& started,
                                           bool act, int hi, int lo, int lr, int q, bf16x8 (&pb)[3][2]) {
    const LAS bf16_t* kbase = Kt + lr * 72 + 8 * q;
    const int hq = hi - 4 * q, lq = lo - 4 * q;
    f32x4 s[3][4];
    {
        f32x4 c0[3];
#pragma unroll
        for (int r = 0; r < 3; ++r) { const float nm = act ? -m[r] : -1e30f; c0[r] = (f32x4){nm, nm, nm, nm}; }
        bf16x8 kf[2][2];
        kf[0][0] = *(const LAS bf16x8*)(kbase); kf[0][1] = *(const LAS bf16x8*)(kbase + 32);
#pragma unroll
        for (int mt = 0; mt < 4; ++mt) {
            if (mt < 3) { kf[(mt + 1) & 1][0] = *(const LAS bf16x8*)(kbase + 16 * (mt + 1) * 72); kf[(mt + 1) & 1][1] = *(const LAS bf16x8*)(kbase + 16 * (mt + 1) * 72 + 32); }
            __builtin_amdgcn_sched_barrier(0);
#pragma unroll
            for (int r = 0; r < 3; ++r) { s[r][mt] = MFMA16(kf[mt & 1][0], qf[r][0], c0[r]); s[r][mt] = MFMA16(kf[mt & 1][1], qf[r][1], s[r][mt]); }
            __builtin_amdgcn_sched_barrier(0);
        }
    }
    float mx[3];
#pragma unroll
    for (int r = 0; r < 3; ++r) {
        if (MASKED) {
#pragma unroll
            for (int mt = 0; mt < 4; ++mt)
#pragma unroll
                for (int i = 0; i < 4; ++i) { s[r][mt][i] = ((16 * mt + i) <= hq && (16 * mt + i) > lq) ? s[r][mt][i] : -1e30f; }
        }
        mx[r] = fmaxf(fmaxf(fmaxf(fmaxf(fmaxf(s[r][0][0], s[r][0][1]), s[r][0][2]), fmaxf(fmaxf(s[r][0][3], s[r][1][0]), s[r][1][1])), fmaxf(fmaxf(s[r][1][2], s[r][1][3]), s[r][2][0])), fmaxf(fmaxf(fmaxf(fmaxf(s[r][2][1], s[r][2][2]), s[r][2][3]), fmaxf(fmaxf(s[r][3][0], s[r][3][1]), s[r][3][2])), s[r][3][3]));
    }
#pragma unroll
    for (int r = 0; r < 3; ++r) mx[r] = pg8::xmax16(mx[r]);
#pragma unroll
    for (int r = 0; r < 3; ++r) mx[r] = pg8::xmax32(mx[r]);
    bool need[3]; bool anyneed = false;
#pragma unroll
    for (int r = 0; r < 3; ++r) { const bool st = ((started >> r) & 1u) != 0u; need[r] = (mx[r] > -1e29f) && (!st || mx[r] > RESC_THR); anyneed = anyneed || need[r]; }
    if (__builtin_amdgcn_ballot_w64(anyneed) != 0ull) {
#pragma unroll
        for (int r = 0; r < 3; ++r) {
            const bool st = ((started >> r) & 1u) != 0u;
            const float dl = need[r] ? mx[r] : 0.f;
            const float alpha = need[r] ? (st ? __builtin_amdgcn_exp2f(-dl) : 0.f) : 1.f;
            m[r] += dl;
#pragma unroll
            for (int mt = 0; mt < 4; ++mt) s[r][mt] = s[r][mt] - dl;
            lacc[r] = lacc[r] * alpha;
#pragma unroll
            for (int dt = 0; dt < 4; ++dt) acc[r][dt] = acc[r][dt] * alpha;
            if (need[r]) started |= (1u << r);
        }
    }
#pragma unroll
    for (int r = 0; r < 3; ++r)
#pragma unroll
        for (int mt = 0; mt < 4; ++mt)
#pragma unroll
            for (int i = 0; i < 4; ++i) s[r][mt][i] = __builtin_amdgcn_exp2f(s[r][mt][i]);
#pragma unroll
    for (int r = 0; r < 3; ++r) {
        pb[r][0] = __builtin_bit_cast(bf16x8, pg8::pack8(s[r][0], s[r][1]));
        pb[r][1] = __builtin_bit_cast(bf16x8, pg8::pack8(s[r][2], s[r][3]));
    }
    __builtin_amdgcn_sched_barrier(0);
}
__device__ __forceinline__ void pv_part(const LAS bf16_t* Vt, const bf16x8 (&pb)[3][2], f32x4 (&lacc)[3], f32x4 (&acc)[3][4], int lr, int q) {
    const LAS bf16_t* vbase = Vt + (4 * q + (lr >> 2)) * 72 + 4 * (lr & 3);
    const bf16x8 ones = (bf16x8){0x3F80, 0x3F80, 0x3F80, 0x3F80, 0x3F80, 0x3F80, 0x3F80, 0x3F80};
    s16x4 vv[2][2];
    vv[0][0] = vtr(vbase); vv[0][1] = vtr(vbase + 16 * 72);
#pragma unroll
    for (int it = 0; it < 8; ++it) {
        const int kk = it >> 2, dt = it & 3;
        if (it < 7) { const int kk2 = (it + 1) >> 2, dt2 = (it + 1) & 3; vv[(it + 1) & 1][0] = vtr(vbase + (32 * kk2) * 72 + 16 * dt2); vv[(it + 1) & 1][1] = vtr(vbase + (32 * kk2 + 16) * 72 + 16 * dt2); }
        __builtin_amdgcn_sched_barrier(0);
        const bf16x8 vf = mk8(vv[it & 1][0], vv[it & 1][1]);
#pragma unroll
        for (int r = 0; r < 3; ++r) acc[r][dt] = MFMA16(vf, pb[r][kk], acc[r][dt]);
        if (dt == 0) {
#pragma unroll
            for (int r = 0; r < 3; ++r) lacc[r] = MFMA16(ones, pb[r][kk], lacc[r]);
        }
        __builtin_amdgcn_sched_barrier(0);
    }
}

__device__ __forceinline__ void tile_importance(const LAS bf16_t* Kt, const bf16x8 (&qf)[3][2], const float (&m)[3], const float (&invl)[3], int hi, LAS float* imp, int tt, int lr, int q) {
    const int hq = hi - 4 * q;
    f32x4 P[4];
#pragma unroll
    for (int mt = 0; mt < 4; ++mt) P[mt] = (f32x4){0.f, 0.f, 0.f, 0.f};
#pragma unroll
    for (int r = 0; r < 3; ++r) {
        const f32x4 c0 = (f32x4){-m[r], -m[r], -m[r], -m[r]};
#pragma unroll
        for (int mt = 0; mt < 4; ++mt) {
            f32x4 s = c0;
#pragma unroll
            for (int ks = 0; ks < 2; ++ks) { const bf16x8 kf = *(const LAS bf16x8*)(Kt + (16 * mt + lr) * 72 + 32 * ks + 8 * q); s = MFMA16(kf, qf[r][ks], s); }
#pragma unroll
            for (int i = 0; i < 4; ++i) { const float p = ((16 * mt + i) <= hq) ? __builtin_amdgcn_exp2f(s[i]) * invl[r] : 0.f; P[mt][i] += p; }
        }
    }
#pragma unroll
    for (int mt = 0; mt < 4; ++mt) {
        const int n = 16 * tt + 4 * mt + q;
        const float own = (P[mt][0] + P[mt][1]) + (P[mt][2] + 0.5f * P[mt][3]), sp = 0.5f * P[mt][3];
        __hip_atomic_fetch_add(&imp[lr * 128 + n], own, __ATOMIC_RELAXED, __HIP_MEMORY_SCOPE_WORKGROUP);
        if (n + 1 < 128) __hip_atomic_fetch_add(&imp[lr * 128 + n + 1], sp, __ATOMIC_RELAXED, __HIP_MEMORY_SCOPE_WORKGROUP);
    }
}

__device__ __forceinline__ void sel_group(const LAS bf16_t* Kt, const LAS bf16_t* Vt, LAS float* S, const bf16x8 qB0, const bf16x8 qB1, int jc, int rc, bool valid, bool masked, int tw64, int lr, int q) {
    LAS float* Srow = S + (jc * 3 + rc) * 68;
    const float mref = Srow[65]; const bool st = Srow[66] != 0.f;
    f32x4 acc[4];
#pragma unroll
    for (int dt = 0; dt < 4; ++dt) acc[dt] = *(const LAS f32x4*)(Srow + 16 * dt + 4 * q);
    float lc = Srow[64];
    const float nm = valid ? -mref : -1e30f;
    const f32x4 c0 = (f32x4){nm, nm, nm, nm};
    const LAS bf16_t* kbase = Kt + lr * 72 + 8 * q;
    f32x4 s[4];
    {
        bf16x8 kf[2][2];
        kf[0][0] = *(const LAS bf16x8*)(kbase); kf[0][1] = *(const LAS bf16x8*)(kbase + 32);
#pragma unroll
        for (int mt = 0; mt < 4; ++mt) {
            if (mt < 3) { kf[(mt + 1) & 1][0] = *(const LAS bf16x8*)(kbase + 16 * (mt + 1) * 72); kf[(mt + 1) & 1][1] = *(const LAS bf16x8*)(kbase + 16 * (mt + 1) * 72 + 32); }
            __builtin_amdgcn_sched_barrier(0);
            __builtin_amdgcn_s_setprio(1); s[mt] = MFMA16(kf[mt & 1][0], qB0, c0); s[mt] = MFMA16(kf[mt & 1][1], qB1, s[mt]); __builtin_amdgcn_s_setprio(0);
            __builtin_amdgcn_sched_barrier(0);
        }
    }
    if (masked) {
        const int hq = tw64 + jc - 4 * q;
#pragma unroll
        for (int mt = 0; mt < 4; ++mt)
#pragma unroll
            for (int i = 0; i < 4; ++i) s[mt][i] = ((16 * mt + i) <= hq) ? s[mt][i] : -1e30f;
    }
    float mx = fmaxf(fmaxf(fmaxf(fmaxf(fmaxf(s[0][0], s[0][1]), s[0][2]), fmaxf(fmaxf(s[0][3], s[1][0]), s[1][1])), fmaxf(fmaxf(s[1][2], s[1][3]), s[2][0])), fmaxf(fmaxf(fmaxf(fmaxf(s[2][1], s[2][2]), s[2][3]), fmaxf(fmaxf(s[3][0], s[3][1]), s[3][2])), s[3][3]));
    mx = pg8::xmax16(mx); mx = pg8::xmax32(mx);
    const bool need = valid && (mx > -1e29f) && (!st || mx > RESC_THR);
    const bool anyneed = __builtin_amdgcn_ballot_w64(need) != 0ull;
    float alpha = 1.f;
    if (anyneed) {
        const float dl = need ? mx : 0.f;
        alpha = need ? (st ? __builtin_amdgcn_exp2f(-dl) : 0.f) : 1.f;
#pragma unroll
        for (int mt = 0; mt < 4; ++mt) s[mt] = s[mt] - dl;
        if (need && q == 0) { Srow[65] = mref + dl; Srow[66] = 1.f; }
    }
#pragma unroll
    for (int mt = 0; mt < 4; ++mt)
#pragma unroll
        for (int i = 0; i < 4; ++i) s[mt][i] = __builtin_amdgcn_exp2f(s[mt][i]);
    bf16x8 pb[2];
    pb[0] = __builtin_bit_cast(bf16x8, pg8::pack8(s[0], s[1]));
    pb[1] = __builtin_bit_cast(bf16x8, pg8::pack8(s[2], s[3]));
    if (anyneed) {
#pragma unroll
        for (int dt = 0; dt < 4; ++dt) acc[dt] = acc[dt] * alpha;
        lc *= alpha;
    }
    f32x4 ls = (f32x4){0.f, 0.f, 0.f, 0.f};
    {
        const LAS bf16_t* vbase = Vt + (4 * q + (lr >> 2)) * 72 + 4 * (lr & 3);
        const bf16x8 ones = (bf16x8){0x3F80, 0x3F80, 0x3F80, 0x3F80, 0x3F80, 0x3F80, 0x3F80, 0x3F80};
        s16x4 vv[2][2];
        vv[0][0] = vtr(vbase); vv[0][1] = vtr(vbase + 16 * 72);
#pragma unroll
        for (int it = 0; it < 8; ++it) {
            const int kk = it >> 2, dt = it & 3;
            if (it < 7) { const int kk2 = (it + 1) >> 2, dt2 = (it + 1) & 3; vv[(it + 1) & 1][0] = vtr(vbase + (32 * kk2) * 72 + 16 * dt2); vv[(it + 1) & 1][1] = vtr(vbase + (32 * kk2 + 16) * 72 + 16 * dt2); }
            __builtin_amdgcn_sched_barrier(0);
            const bf16x8 vf = mk8(vv[it & 1][0], vv[it & 1][1]);
            __builtin_amdgcn_s_setprio(1); acc[dt] = MFMA16(vf, pb[kk], acc[dt]);
            if (dt == 0) ls = MFMA16(ones, pb[kk], ls);
            __builtin_amdgcn_s_setprio(0);
            __builtin_amdgcn_sched_barrier(0);
        }
    }
    if (valid) {
#pragma unroll
        for (int dt = 0; dt < 4; ++dt) *(LAS f32x4*)(Srow + 16 * dt + 4 * q) = acc[dt];
        if (q == 0) Srow[64] = lc + ls[0];
    }
}

struct KVRegs { u32x4 k, v; };
__device__ __forceinline__ void kv_fetch(KVRegs& R, const bf16_t* gK, const bf16_t* gV, int tid, bool withv) {
    R.k = *(const GAS u32x4*)(gK + tid * 8);
    if (withv) R.v = *(const GAS u32x4*)(gV + tid * 8);
}
__device__ __forceinline__ void kv_commit(const KVRegs& R, LAS bf16_t* Kt, LAS bf16_t* Vt, int tid, bool withv) {
    const int key = tid >> 3, dc = tid & 7;
    *(LAS u32x4*)(Kt + key * 72 + dc * 8) = R.k;
    if (withv) *(LAS u32x4*)(Vt + key * 72 + dc * 8) = R.v;
}

__device__ __forceinline__ void nsa_phase(LAS unsigned char* lds, const bf16_t* Q, const bf16_t* KVG, size_t kvg_stride, const bf16_t* kcc, const bf16_t* vcc, const float* G, bf16_t* cat,
                                          int tid, int lane, int wave) {
    LAS bf16_t* Kb0 = (LAS bf16_t*)lds;
    LAS bf16_t* Vb0 = (LAS bf16_t*)(lds + 2 * 64 * 72 * 2);
    LAS float* imp = (LAS float*)(lds + 5 * 64 * 72 * 2) + wave * 3264;
    LAS float* Ssel = imp;
    LAS unsigned* selw = (LAS unsigned*)(lds + 5 * 64 * 72 * 2 + NWAVES * 3264 * 4) + wave * 64;
    LAS unsigned* slist = (LAS unsigned*)(lds + 5 * 64 * 72 * 2 + NWAVES * 3264 * 4 + NWAVES * 256) + wave * 16;
    const bf16_t* KS = KVG + 2 * kvg_stride; (void)KS;
    for (int u = blockIdx.x; u < 2048; u += gridDim.x) {
        const int rnd = u >> 8, cc = u & 255, xq = cc & 7, bg = 4 * rnd + (xq >> 1), ii = (xq & 1) * 32 + (cc >> 3), iq = (rnd & 1) ? 63 - ii : ii;
        const int b = bg >> 2, g = bg & 3, t0 = 128 * iq;
        int lane_u; asm volatile("v_mbcnt_lo_u32_b32 %0, -1, 0\n\tv_mbcnt_hi_u32_b32 %0, -1, %0" : "=&v"(lane_u));
        const int lr = lane_u & 15, q = lane_u >> 4;
        const int t = t0 + 16 * wave + lr; const size_t rowu = (size_t)b * SEQ + t0; const unsigned tl = (unsigned)(16 * wave + lr);
        const bf16_t* Qp = Q + rowu * 768 + 3 * g * 64; const float* Gp = G + rowu * 36 + 9 * g; bf16_t* catp = cat + rowu * 1024 + 3 * g * 64;
        bf16x8 qf[3][2];
#pragma unroll
        for (int r = 0; r < 3; ++r)
#pragma unroll
            for (int ks = 0; ks < 2; ++ks) qf[r][ks] = *(const GAS bf16x8*)(Qp + (tl * 768u + (unsigned)(r * 64 + 32 * ks + 8 * q)));
        const int ntc = (8 * iq + 7 + 63) >> 6;
        const int cmaxv = (t - 31) >> 4;
#pragma unroll 1
        for (int br = 0; br < 3; ++br) {
            const bf16_t* gK; const bf16_t* gV; int nbeg, nend, hbase;
            if (br == 0) { gK = kcc + (size_t)bg * 512 * 64; gV = vcc + (size_t)bg * 512 * 64; nbeg = 0; nend = ntc; hbase = cmaxv; }
            else { gK = KVG + (size_t)(2 * br) * kvg_stride + (size_t)bg * SEQ * 64; gV = gK + kvg_stride; nbeg = (br == 2 && 2 * iq - 8 > 0) ? 2 * iq - 8 : 0; nend = 2 * iq + 2; hbase = t; }
            if (br == 1) {
                float zs_ = 0.f; asm volatile("" : "+v"(zs_));
                int lane_c = lane_u; asm volatile("" : "+v"(lane_c));
                const int lr = lane_c & 15, q = lane_c >> 4;
#pragma unroll
                for (int i = 0; i < 13; ++i) { const int e4 = lane_u + 64 * i; if (e4 < 816) *(LAS f32x4*)(Ssel + e4 * 4) = (f32x4){zs_, zs_, zs_, zs_}; }
                KVRegs R;
                __syncthreads();
                int tb = wave * 64 + lane_u; asm volatile("" : "+v"(tb));
                kv_fetch(R, gK + (size_t)nbeg * 4096, gV + (size_t)nbeg * 4096, tb, true);
                int kc_ = 0;
                const GAS bf16_t* Qw = (const GAS bf16_t*)(Qp + (size_t)(16 * wave) * 768);
                const unsigned w_own = selw[lr * 4 + q];
                for (int n = nbeg; n < nend; ++n) {
                    LAS bf16_t* Kt = Kb0 + kc_ * 64 * 72; LAS bf16_t* Vt = Vb0 + kc_ * 64 * 72;
                    kv_commit(R, Kt, Vt, tb, true);
                    const bool bitn = ((w_own >> (n & 31)) & 1u) != 0u;
                    const unsigned mask16 = (unsigned)((__builtin_amdgcn_ballot_w64(bitn) >> (16 * (n >> 5))) & 0xFFFFull);
                    const int ksel = __builtin_popcount(mask16);
                    const bool act = ((mask16 >> lr) & 1u) != 0u;
                    if (act && q == 0) slist[__builtin_popcount(mask16 & ((1u << lr) - 1u))] = (unsigned)lr;
                    asm volatile("s_waitcnt lgkmcnt(0)" ::: "memory");
                    int jcg[3], rcg[3]; bool vg[3]; bf16x8 qB[3][2]; unsigned sl[3];
#pragma unroll
                    for (int gi = 0; gi < 3; ++gi) sl[gi] = slist[((16 * gi + lr) * 43) >> 7];
#pragma unroll
                    for (int gi = 0; gi < 3; ++gi) {
                        const int cg = 16 * gi + lr, idx = (cg * 43) >> 7; rcg[gi] = cg - 3 * idx; vg[gi] = idx < ksel;
                        jcg[gi] = vg[gi] ? (int)sl[gi] : 0;
                        const GAS bf16_t* qg = Qw + (jcg[gi] * 768 + rcg[gi] * 64 + 8 * q);
                        qB[gi][0] = *(const GAS bf16x8*)qg; qB[gi][1] = *(const GAS bf16x8*)(qg + 32);
                    }
                    if (n + 1 < nend) kv_fetch(R, gK + (size_t)(n + 1) * 4096, gV + (size_t)(n + 1) * 4096, tb, true);
                    __syncthreads();
                    const int ng = (3 * ksel + 15) >> 4;
                    const bool msk = (n == ((t0 + 16 * wave) >> 6));
#pragma unroll
                    for (int gi = 0; gi < 3; ++gi)
                        if (gi < ng) sel_group(Kt, Vt, Ssel, qB[gi][0], qB[gi][1], jcg[gi], rcg[gi], vg[gi], msk, t0 + 16 * wave - 64 * n, lr, q);
                    kc_ ^= 1;
                }
                int lane_f = lane_u; asm volatile("" : "+v"(lane_f));
                const int lrf = lane_f & 15, qf_ = lane_f >> 4; const unsigned tlf_ = (unsigned)(16 * wave + lrf);
#pragma unroll
                for (int r = 0; r < 3; ++r) {
                    const float gt_ = ((const GAS float*)Gp)[tlf_ * 36u + (unsigned)(r * 3 + 1)];
                    const LAS float* Sr = Ssel + (lrf * 3 + r) * 68;
                    const float l1 = Sr[64]; const float sc_ = l1 > 0.f ? gt_ * __builtin_amdgcn_rcpf(l1) : 0.f;
#pragma unroll
                    for (int dt = 0; dt < 4; ++dt) {
                        f32x4 o = *(const LAS f32x4*)(Sr + 16 * dt + 4 * qf_) * sc_;
                        GAS u32x2* cp = (GAS u32x2*)(catp + (tlf_ * 1024u + (unsigned)(r * 64 + 16 * dt + 4 * qf_)));
                        const u32x2 old_ = *cp; o[0] += __uint_as_float(old_.x << 16); o[1] += __uint_as_float(old_.x & 0xffff0000u); o[2] += __uint_as_float(old_.y << 16); o[3] += __uint_as_float(old_.y & 0xffff0000u);
                        u32x2 w_; w_.x = cvt_pk_bf16(o[0], o[1]); w_.y = cvt_pk_bf16(o[2], o[3]); *cp = w_;
                    }
                }
                asm volatile("s_waitcnt lgkmcnt(0)" ::: "memory");
                continue;
            }
            float zf_ = 0.f; asm volatile("" : "+v"(zf_));
            float m[3]; f32x4 lacc[3]; f32x4 acc[3][4]; unsigned started = __float_as_uint(zf_);
#pragma unroll
            for (int r = 0; r < 3; ++r) { m[r] = zf_; lacc[r] = (f32x4){zf_, zf_, zf_, zf_};
#pragma unroll
                for (int dt = 0; dt < 4; ++dt) acc[r][dt] = (f32x4){zf_, zf_, zf_, zf_}; }
            KVRegs R;
            __syncthreads();
            int tb = wave * 64 + lane_u; asm volatile("" : "+v"(tb));
            kv_fetch(R, gK + (size_t)nbeg * 4096, gV + (size_t)nbeg * 4096, tb, true);
            int kc_ = 0;
            for (int n = nbeg; n < nend; ++n) {
                LAS bf16_t* Kt = Kb0 + kc_ * 64 * 72; LAS bf16_t* Vt = Vb0 + kc_ * 64 * 72;
                kv_commit(R, Kt, Vt, tb, true);
                if (n + 1 < nend) kv_fetch(R, gK + (size_t)(n + 1) * 4096, gV + (size_t)(n + 1) * 4096, tb, true);
                __syncthreads();
                const int hi = hbase - 64 * n, lo = (br == 2) ? t - 512 - 64 * n : -1;
                const bool act = hi >= 0 && lo < 63;
                if (__builtin_amdgcn_ballot_w64(act) != 0ull) {
                    bf16x8 pb[3][2];
                    if (__builtin_amdgcn_ballot_w64(act && (hi < 63 || lo >= 0)) != 0ull) qk_softmax<true>(Kt, qf, m, lacc, acc, started, act, hi, lo, lr, q, pb);
                    else qk_softmax<false>(Kt, qf, m, lacc, acc, started, act, hi, lo, lr, q, pb);
                    pv_part(Vt, pb, lacc, acc, lr, q);
                }
                kc_ ^= 1;
            }
            float invl[3];
#pragma unroll
            for (int r = 0; r < 3; ++r) { const float lt = lacc[r][0]; invl[r] = lt > 0.f ? __builtin_amdgcn_rcpf(lt) : 0.f; }
            if (br == 0) {
                int lane_k = lane_u; asm volatile("" : "+v"(lane_k));
                const int lr = lane_k & 15, q = lane_k >> 4;
#pragma unroll
                for (int i = 0; i < 8; ++i) *(LAS f32x4*)(imp + lane_k * 32 + i * 4) = (f32x4){zf_, zf_, zf_, zf_};
                asm volatile("s_waitcnt lgkmcnt(0)" ::: "memory");
                __syncthreads();
                int tk = wave * 64 + lane_k; asm volatile("" : "+v"(tk));
                u32x4 rk = *(const GAS u32x4*)(gK + tk * 8);
                for (int tt = 0; tt < ntc; ++tt) {
                    LAS bf16_t* Kt = Kb0 + (tt & 1) * 64 * 72;
                    *(LAS u32x4*)(Kt + (tk >> 3) * 72 + (tk & 7) * 8) = rk;
                    if (tt + 1 < ntc) rk = *(const GAS u32x4*)(gK + (size_t)(tt + 1) * 4096 + tk * 8);
                    __syncthreads();
                    const int hi = cmaxv - 64 * tt;
                    if (__builtin_amdgcn_ballot_w64(hi >= 0) != 0ull) tile_importance(Kt, qf, m, invl, hi, imp, tt, lr, q);
                }
                asm volatile("s_waitcnt lgkmcnt(0)" ::: "memory");
                const int cur = (t0 + 16 * wave) >> 6;
                unsigned word = 0u;
                if (cur <= 15) { if (q == 0) word = (1u << (cur + 1)) - 1u; }
                else {
                    unsigned v[32];
#pragma unroll
                    for (int i = 0; i < 8; ++i) { const f32x4 xv = *(const LAS f32x4*)(imp + lr * 128 + 32 * q + 4 * i);
#pragma unroll
                        for (int e = 0; e < 4; ++e) { const int j = 4 * i + e, n = 32 * q + j; const unsigned key = (__float_as_uint(xv[e]) & ~0x7Fu) | (unsigned)(127 - n); v[j] = (n < 1 || n > cur - 2) ? 0u : key; } }
                    for (int rd = 0; rd < 13; ++rd) {
                        unsigned best = v[0];
#pragma unroll
                        for (int j = 1; j < 32; ++j) best = best > v[j] ? best : v[j];
                        { const auto r1 = __builtin_amdgcn_permlane16_swap(best, best, false, false); best = r1[0] > r1[1] ? r1[0] : r1[1]; }
                        { const auto r2 = __builtin_amdgcn_permlane32_swap(best, best, false, false); best = r2[0] > r2[1] ? r2[0] : r2[1]; }
                        const int nw = 127 - (int)(best & 0x7Fu);
                        if ((nw >> 5) == q) word |= 1u << (nw & 31);
#pragma unroll
                        for (int j = 0; j < 32; ++j) v[j] = (v[j] == best) ? 0u : v[j];
                    }
                    if (q == 0) word |= 1u;
                    if ((cur >> 5) == q) word |= 1u << (cur & 31);
                    if (((cur - 1) >> 5) == q) word |= 1u << ((cur - 1) & 31);
                }
                selw[lr * 4 + q] = word;
                asm volatile("s_waitcnt lgkmcnt(0)" ::: "memory");
            }
            {
                int lane_f = lane_u; asm volatile("" : "+v"(lane_f));
                const int lr = lane_f & 15, q = lane_f >> 4; const unsigned tlf_ = (unsigned)(16 * wave + lr);
#pragma unroll
                for (int r = 0; r < 3; ++r) {
                    const float gt_ = ((const GAS float*)Gp)[tlf_ * 36u + (unsigned)(r * 3 + br)];
                    const float sc_ = gt_ * invl[r];
#pragma unroll
                    for (int dt = 0; dt < 4; ++dt) {
                        f32x4 o = acc[r][dt] * sc_;
                        GAS u32x2* cp = (GAS u32x2*)(catp + (tlf_ * 1024u + (unsigned)(r * 64 + 16 * dt + 4 * q)));
                        if (br > 0) { const u32x2 old_ = *cp; o[0] += __uint_as_float(old_.x << 16); o[1] += __uint_as_float(old_.x & 0xffff0000u); o[2] += __uint_as_float(old_.y << 16); o[3] += __uint_as_float(old_.y & 0xffff0000u); }
                        u32x2 w_; w_.x = cvt_pk_bf16(o[0], o[1]); w_.y = cvt_pk_bf16(o[2], o[3]); *cp = w_;
                    }
                }
                asm volatile("s_waitcnt lgkmcnt(0)" ::: "memory");
            }
        }
    }
}

__device__ __forceinline__ void final_norm_phase(float* x, const float* ssq, const float* gfin, int lane, int wave) {
    const int gw = blockIdx.x * NWAVES + wave, NGW = gridDim.x * NWAVES;
    f32x4 gv[4];
#pragma unroll
    for (int j = 0; j < 4; ++j) gv[j] = ((const f32x4*)gfin)[64 * j + lane];
    for (int row = gw; row < MTOK; row += 2 * NGW) {
        const bool has2 = row + NGW < MTOK; const int row2 = has2 ? row + NGW : row;
        const float rinv = pg8::row_rinv16(ssq, row), rinv2 = pg8::row_rinv16(ssq, row2);
        GAS f32x4* xr = (GAS f32x4*)(x + (size_t)row * DM) + lane; GAS f32x4* xr2 = (GAS f32x4*)(x + (size_t)row2 * DM) + lane;
        f32x4 v[4], w[4];
#pragma unroll
        for (int j = 0; j < 4; ++j) { v[j] = xr[64 * j]; w[j] = xr2[64 * j]; }
#pragma unroll
        for (int j = 0; j < 4; ++j) { xr[64 * j] = v[j] * rinv * gv[j]; if (has2) xr2[64 * j] = w[j] * rinv2 * gv[j]; }
    }
}

typedef unsigned v4u_unused_ __attribute__((ext_vector_type(4)));
#define XB_TMO      128
#define XB_XCNT(j)  (256  + 64 * (j))
#define XB_XSUB(j)  (1280 + 64 * (j))
#define XB_XGEN(j)  (2304 + 64 * (j))
#define XB_TOP      3328
#define XB_TOPGEN   3392
#define XCD_BAR_WORDS 3456
#define XB_SPIN_CAP (1u << 18)

__device__ __forceinline__ unsigned xb_ld(unsigned* p)              { return __hip_atomic_load(p, __ATOMIC_RELAXED, __HIP_MEMORY_SCOPE_AGENT); }
__device__ __forceinline__ unsigned xb_add(unsigned* p, unsigned v) { return __hip_atomic_fetch_add(p, v, __ATOMIC_RELAXED, __HIP_MEMORY_SCOPE_AGENT); }
__device__ __forceinline__ unsigned xb_xcc_id() { return (unsigned)__builtin_amdgcn_s_getreg((3 << 11) | 20) & 0xFu; }
#define XB_SPIN(cond, bar) do { unsigned _sp = 0; while (cond) { __builtin_amdgcn_s_sleep(1); \
    if ((++_sp & 255u) == 0u) { if (xb_ld(&(bar)[XB_TMO])) break; if (_sp > XB_SPIN_CAP) { atomicAdd(&(bar)[XB_TMO], 1u); break; } } } } while (0)

struct XcdBarrier {
    unsigned* bar; unsigned x;
    volatile LAS unsigned* st;
};

__device__ __forceinline__ XcdBarrier xcd_barrier_post(unsigned* bar, volatile LAS unsigned* st) {
    XcdBarrier b; b.bar = bar; b.x = xb_xcc_id(); b.st = st;
    if (threadIdx.x == 0) (void)xb_add(&bar[XB_XCNT(b.x)], 1u);
    return b;
}
__device__ __forceinline__ void xcd_barrier_complete(unsigned* bar, unsigned x, unsigned& nloc, unsigned& nx) {
    const unsigned G = gridDim.x * gridDim.y * gridDim.z;
    unsigned sum, cnt, mine, sp = 0u;
    for (;;) {
        sum = 0u; cnt = 0u; mine = 0u;
#pragma unroll
        for (unsigned j = 0; j < 16; ++j) { const unsigned c = xb_ld(&bar[XB_XCNT(j)]); sum += c; cnt += (c > 0u) ? 1u : 0u; mine = (j == x) ? c : mine; }
        if (sum == G) break;
        __builtin_amdgcn_s_sleep(1);
        if ((++sp & 255u) == 0u) { if (xb_ld(&bar[XB_TMO])) break; if (sp > XB_SPIN_CAP) { atomicAdd(&bar[XB_TMO], 1u); break; } }
    }
    nloc = mine > 0u ? mine : 1u; nx = cnt > 0u ? cnt : 1u;
}

__device__ __forceinline__ void xcd_barrier(const XcdBarrier& b) {
    asm volatile("s_waitcnt vmcnt(0)" ::: "memory");
    __syncthreads();
    if (threadIdx.x == 0) {
        unsigned* bar = b.bar;
        __builtin_amdgcn_s_waitcnt(0);
        unsigned nloc = b.st[0], nx = b.st[1];
        if (nloc == 0u) { xcd_barrier_complete(bar, b.x, nloc, nx); b.st[0] = nloc; b.st[1] = nx; }
        const unsigned old = xb_add(&bar[XB_XSUB(b.x)], 1u);
        const unsigned gen = old / nloc;
        if (old + 1u == (gen + 1u) * nloc) {
            __builtin_amdgcn_fence(__ATOMIC_RELEASE, "agent");
            asm volatile("s_waitcnt vmcnt(0)" ::: "memory");
            const unsigned og = xb_add(&bar[XB_TOP], 1u);
            const unsigned tg = og / nx;
            if (og + 1u == (tg + 1u) * nx) xb_add(&bar[XB_TOPGEN], 1u);
            else XB_SPIN(xb_ld(&bar[XB_TOPGEN]) == tg, bar);
            __builtin_amdgcn_fence(__ATOMIC_ACQUIRE, "agent");
            xb_add(&bar[XB_XGEN(b.x)], 1u);
            asm volatile("s_waitcnt vmcnt(0)" ::: "memory");
        } else {
            XB_SPIN(xb_ld(&bar[XB_XGEN(b.x)]) == gen, bar);
            __builtin_amdgcn_fence(__ATOMIC_ACQUIRE, "agent");
            asm volatile("s_waitcnt vmcnt(0)" ::: "memory");
        }
    }
    __syncthreads();
}

constexpr int LDS_BYTES = 155648;
constexpr int N_PHASES = 26;
__global__ void __launch_bounds__(NTHREADS, 2) fwd_megakernel(Args a) {
    extern __shared__ __attribute__((aligned(16))) unsigned char lds_raw[];
    LAS unsigned char* lds = (LAS unsigned char*)lds_raw;
    volatile LAS unsigned* bar_st = (volatile LAS unsigned*)(lds + LDS_BYTES - 64);
    if (threadIdx.x < 16) bar_st[threadIdx.x] = 0u;
    __syncthreads();
    XcdBarrier xbar = xcd_barrier_post((unsigned*)(a.ws + WS_CTL_BAR), bar_st);
    const int wave_s_ = __builtin_amdgcn_readfirstlane((int)threadIdx.x >> 6);
#define TIDS() unsigned char* ws = a.ws; asm volatile("" : "+s"(ws)); ws = (unsigned char*)(__attribute__((address_space(1))) unsigned char*)ws;     int tid; asm volatile("v_mbcnt_lo_u32_b32 %0, -1, 0\n\tv_mbcnt_hi_u32_b32 %0, -1, %0" : "=&v"(tid)); tid += wave_s_ * 64; asm volatile("" : "+v"(tid)); const int lane = tid & 63, wave = __builtin_amdgcn_readfirstlane(tid >> 6); (void)lane; (void)wave
    const int lo = a.ph_lo, hi = a.ph_hi;
#define xb ((bf16_t*)(ws + WS_XB))
#define cat ((bf16_t*)(ws + WS_CAT))
#define ssq ((float*)(ws + WS_SSQ))
#define vssq ((float*)(ws + WS_VSSQ))
#define G ((float*)(ws + WS_G))
#define MQ ((bf16_t*)(ws + WS_MQ))
#define memKV ((bf16_t*)(ws + WS_MEMKV))
#define PU ((bf16_t*)(ws + WS_PROJ))
#define PV ((bf16_t*)(ws + WS_PROJ + 96 * MiB))
#define KVG ((bf16_t*)(ws + WS_PROJ + 96 * MiB))
#define hid ((bf16_t*)(ws + WS_PROJ))
#define kcc ((bf16_t*)(ws + WS_KCC))
#define vcc ((bf16_t*)(ws + WS_VCC))
#define Hc ((bf16_t*)(ws + WS_HC))
#define wb (ws + WS_W + (size_t)i * W_STRIDE)
#define xres (a.out)
    const size_t kvg_stride = KVG_STRIDE_B / 2;
    int k = 0;
#define RUN(kk) (lo <= (kk) && (kk) < hi)
#if MK_MULTI
#define SEAM() do { ++k; } while (0)
#else
#define SEAM() do { if (RUN(k) && RUN(k + 1)) { if (lo < 0) cg::this_grid().sync(); else xcd_barrier(xbar); } ++k; } while (0)
#endif
    const int G_ = (int)gridDim.x, bx = (int)blockIdx.x;

    if (RUN(k)) { TIDS(); p0_prologue(a, lds, tid, lane, wave); }
    SEAM();

    for (int i = 0; i < 4; ++i) {
        const int j = i >> 1; const bool odd = (i & 1) != 0;
        if (RUN(k)) {
            TIDS();
            if (i == 0) {
                float* b1 = (float*)(ws + WS_MISC + OFF_BIAS1); const float* bp = (const float*)(ws + WS_MISC + OFF_BIAS1P);
                for (int e = bx * NTHREADS + tid; e < 1024; e += G_ * NTHREADS) { float s = 0.f; for (int ks = 0; ks < 16; ++ks) s += bp[((e >> 8) * 16 + ks) * 256 + (e & 255)]; b1[e] = s; }
            }
            if (!odd) {
                pg8::Gemm g{xb, (const bf16_t*)(wb + OFF_IN), MTOK, 1792, 1024, 1024}; pg8::StaticOrder S; S.init(MTOK, 1792, G_, bx, 1);
                pg8::EpiGmlpIn E{ssq, PU, PV, MQ, vssq};
                pg8::gemm_phase<pg8::EpiGmlpIn, pg8::StaticOrder, true, true>(lds, g, S, E, tid);
            } else {
                pg8::Gemm g{xb, (const bf16_t*)(wb + OFF_IN), MTOK, 2816, 1024, 1024}; pg8::StaticOrder S; S.init(MTOK, 2816, G_, bx, 1);
                pg8::EpiNsaIn E{ssq, (const float*)(ws + WS_ROPE), PU, KVG, MQ, G, kvg_stride};
                pg8::gemm_phase<pg8::EpiNsaIn, pg8::StaticOrder, true, true>(lds, g, S, E, tid);
            }
            if (i == 0) {
                pg8::Gemm g{(const bf16_t*)(ws + WS_MEMB), (const bf16_t*)(ws + WS_WMKV), 2048, 2048, 1024, 1024}; pg8::StaticOrder S; S.init(2048, 2048, G_, bx);
                pg8::EpiMemKV E{(const float*)(ws + WS_MISC + OFF_MEMRINV), memKV};
                pg8::gemm_phase<pg8::EpiMemKV, pg8::StaticOrder, true, true>(lds, g, S, E, tid);
            }
        }
        SEAM();
        if (!odd) {
            if (RUN(k)) {
                TIDS();
                spatial_phase(lds, PU, PV, vssq, a.in[11] + j * 768, a.in[13] + j * 12 * 128, (const bf16_t*)(wb + OFF_WSB), cat, tid, lane, wave);
                memattn_phase(lds, MQ, memKV, i, cat, tid, lane, wave, bx, G_);
            }
            SEAM();
        } else {
            if (RUN(k)) {
                TIDS();
                int bxs = bx; asm volatile("" : "+s"(bxs));
                const int which = bxs >= 64 ? 1 : 0; const int c = bxs < 128 ? (bxs & 63) : (1 << 20);
                pg8::Gemm g{KVG + (size_t)which * kvg_stride, (const bf16_t*)(wb + (which ? OFF_CV1 : OFF_CK1)), 16384, 256, 2048, 1024}; pg8::StaticOrder S; S.init(16384, 256, G_, c);
                pg8::EpiCmp1 E{(const float*)(ws + WS_MISC + OFF_BIAS1) + (j * 2 + which) * 256, Hc + (size_t)which * 16384 * 256};
                pg8::gemm_phase<pg8::EpiCmp1, pg8::StaticOrder, true, true>(lds, g, S, E, tid);
                if (bxs >= 128) memattn_phase(lds, MQ, memKV, i, cat, tid, lane, wave, bxs - 128, G_ - 128);
            }
            SEAM();
            if (RUN(k)) {
                TIDS();
                cmp2_phase(Hc, (const bf16_t*)(wb + OFF_CK2), (const bf16_t*)(wb + OFF_CV2), kcc, vcc, lane, wave);
                if (G_ <= 128) memattn_phase(lds, MQ, memKV, i, cat, tid, lane, wave, bx, G_);
            }
            SEAM();
            if (RUN(k)) { TIDS(); nsa_phase(lds, PU, KVG, kvg_stride, kcc, vcc, G, cat, tid, lane, wave); }
            SEAM();
        }
        if (RUN(k)) {
            TIDS();
            pg8::Gemm g{cat, (const bf16_t*)(wb + OFF_OUT), MTOK, 1024, 1024, 1024}; pg8::StaticOrder S; S.init(MTOK, 1024, G_, bx);
            pg8::EpiResid E{(i == 0) ? a.in[0] : (const float*)xres, xres, xb, ssq};
            pg8::gemm_phase<pg8::EpiResid, pg8::StaticOrder, true, true>(lds, g, S, E, tid);
        }
        SEAM();
        if (RUN(k)) {
            TIDS();
            pg8::Gemm g{xb, (const bf16_t*)(wb + OFF_GU), MTOK, 5632, 1024, 1024}; pg8::StaticOrder S; S.init(MTOK, 5632, G_, bx, 1);
            pg8::EpiGateUp E{ssq, hid};
            pg8::gemm_phase<pg8::EpiGateUp, pg8::StaticOrder, true, true>(lds, g, S, E, tid);
        }
        SEAM();
        if (RUN(k)) {
            TIDS();
            pg8::Gemm g{hid, (const bf16_t*)(wb + OFF_D), MTOK, 1024, 2816, 2816}; pg8::StaticOrder S; S.init(MTOK, 1024, G_, bx);
            pg8::EpiResid E{(const float*)xres, xres, xb, ssq};
            pg8::gemm_phase<pg8::EpiResid, pg8::StaticOrder, true, true>(lds, g, S, E, tid);
        }
        SEAM();
    }
    if (RUN(k)) { TIDS(); final_norm_phase(xres, ssq, a.in[5], lane, wave); }
#undef RUN
#undef SEAM
#undef xb
#undef cat
#undef ssq
#undef vssq
#undef G
#undef MQ
#undef memKV
#undef PU
#undef PV
#undef KVG
#undef hid
#undef kcc
#undef vcc
#undef Hc
#undef wb
#undef xres
}

extern "C" void kernel_launch(void* const* d_in, const int* in_sizes, int n_in, void* d_out, int out_size, void* d_ws, size_t ws_size, hipStream_t stream) {
    static int grid = 0;
    if (grid == 0) {
        if (n_in != 23 || out_size != MTOK * DM || ws_size < WS_END) { fprintf(stderr, "kernel_launch: unexpected shapes (n_in %d out %d ws %zu need %zu)\n", n_in, out_size, ws_size, (size_t)WS_END); grid = -1; return; }
        int dev = 0, cus = 0, per_cu = 0;
        hipGetDevice(&dev); hipDeviceGetAttribute(&cus, hipDeviceAttributeMultiprocessorCount, dev);
        if (hipFuncSetAttribute((const void*)fwd_megakernel, hipFuncAttributeMaxDynamicSharedMemorySize, LDS_BYTES) != hipSuccess) { fprintf(stderr, "kernel_launch: hipFuncSetAttribute failed\n"); grid = -1; return; }
        if (hipOccupancyMaxActiveBlocksPerMultiprocessor(&per_cu, (const void*)fwd_megakernel, NTHREADS, LDS_BYTES) != hipSuccess || per_cu < 1) { fprintf(stderr, "kernel_launch: occupancy query says %d\n", per_cu); per_cu = 1; }
        (void)hipGetLastError();
        grid = cus;
        if (grid > 256) grid = 256;
    }
    if (grid < 0) return;
    if (hipMemsetAsync((char*)d_ws + WS_CTL_BAR, 0, 16384, stream) != hipSuccess) { fprintf(stderr, "kernel_launch: memset of the barrier words failed\n"); return; }
    Args a{};
    for (int i = 0; i < 23; ++i) a.in[i] = (const float*)d_in[i];
    a.out = (float*)d_out; a.ws = (unsigned char*)d_ws;
#if MK_MULTI
    for (int p = 0; p < N_PHASES; ++p) { a.ph_lo = p; a.ph_hi = p + 1; hipLaunchKernelGGL(fwd_megakernel, dim3(grid), dim3(NTHREADS), LDS_BYTES, stream, a); }
#else
    a.ph_lo = 0; a.ph_hi = N_PHASES;
    void* args[] = {&a};
    hipError_t e = hipLaunchCooperativeKernel((const void*)fwd_megakernel, dim3(grid), dim3(NTHREADS), args, LDS_BYTES, stream);
    if (e != hipSuccess) fprintf(stderr, "kernel_launch: cooperative launch failed: %s (grid %d)\n", hipGetErrorString(e), grid);
#endif
}
```
